# Optimizing an MI355X kernel written in HIP

```python
import jax, jax.numpy as jnp
from jax import lax
import numpy as np

D_MODEL = 2048
BATCH = 4
SEQ = 2048
DEPTH = 2

GRID_W = 64
CTX_LEN = 256

D_MLSTM = D_MODEL // 2
N_MLSTM_HEADS = 4
MLSTM_HEAD_DIM = D_MLSTM // N_MLSTM_HEADS
MLSTM_CHUNK = 64
QK_CONV = 3
N_DIR = 2
D_POOL = D_MODEL - D_MLSTM
POOL_WINDOWS = (2, 4, 8, 16)
N_POOL_GROUPS = len(POOL_WINDOWS)
POOL_GROUP_DIM = D_POOL // N_POOL_GROUPS
N_GATE = 2 * N_DIR * N_MLSTM_HEADS
N_IN_EVEN = 5 * D_MLSTM + N_GATE + 2 * D_POOL
EVEN_SPLITS = (D_MLSTM, 2 * D_MLSTM, 3 * D_MLSTM, 4 * D_MLSTM, 5 * D_MLSTM,
               5 * D_MLSTM + N_GATE, 5 * D_MLSTM + N_GATE + D_POOL)
D_SGU = D_MODEL
N_SGU_HEADS = 8
SGU_HEAD_DIM = D_SGU // N_SGU_HEADS
SGU_CHUNK = 128
N_IN_ODD = 3 * D_SGU

N_EVEN = (DEPTH + 1) // 2
N_ODD = DEPTH // 2
DEEPNORM_ALPHA = (2.0 * DEPTH) ** 0.25
DEEPNORM_BETA = (8.0 * DEPTH) ** -0.25
LN_EPS = 1e-5

kernel_name = "hybrid_mlstm_pool_sgu_deepnorm_prefix"


def _normalize(x):
    xf = x.astype(jnp.float32)
    mu = xf.mean(-1, keepdims=True)
    var = jnp.square(xf - mu).mean(-1, keepdims=True)
    return (xf - mu) * lax.rsqrt(var + LN_EPS)


def layer_norm(x, g, b):
    return (_normalize(x) * g + b).astype(x.dtype)


def ada_params(cond, w, b):
    mod = jax.nn.silu(cond) @ w + b
    return jnp.split(mod, 3, axis=-1)


def dwconv_centered(x, w):
    k, ch = w.shape
    return lax.conv_general_dilated(x, w[:, None, :].astype(x.dtype), window_strides=(1,),
                                    padding=[(k // 2, k // 2)],
                                    dimension_numbers=('NWC', 'WIO', 'NWC'),
                                    feature_group_count=ch)


def mlstm_scan(q, k, v, log_i, log_f, state):
    bsz, nh, seqlen, dh = q.shape
    nc = seqlen // MLSTM_CHUNK

    def to_chunks(a):
        a = a.astype(jnp.float32).reshape(bsz, nh, nc, MLSTM_CHUNK, *a.shape[3:])
        return jnp.moveaxis(a, 2, 0)

    lower = jnp.tril(jnp.ones((MLSTM_CHUNK, MLSTM_CHUNK), bool))

    def step(carry, inp):
        cmat, nvec, m = carry
        qc, kc, vc, ic, fc = inp
        b = jnp.cumsum(fc, axis=-1)
        d = b[..., :, None] - b[..., None, :] + ic[..., None, :]
        d = jnp.where(lower, d, -jnp.inf)
        inter = b + m[..., None]
        m_t = jnp.maximum(d.max(-1), inter)
        w_intra = jnp.exp(d - m_t[..., None])
        w_inter = jnp.exp(inter - m_t)
        s = jnp.einsum('bhtd,bhsd->bhts', qc, kc) * w_intra
        num = (jnp.einsum('bhts,bhsd->bhtd', s, vc)
               + w_inter[..., None] * jnp.einsum('bhvk,bhtk->bhtv', cmat, qc))
        den = s.sum(-1) + w_inter * jnp.einsum('bhk,bhtk->bht', nvec, qc)
        h = num / jnp.maximum(jnp.abs(den), jnp.exp(-m_t))[..., None]
        b_last = b[..., -1]
        g = b_last[..., None] - b + ic
        m_new = jnp.maximum(b_last + m, g.max(-1))
        w_s = jnp.exp(g - m_new[..., None])
        decay = jnp.exp(b_last + m - m_new)
        c_new = decay[..., None, None] * cmat + jnp.einsum('bhs,bhsv,bhsk->bhvk', w_s, vc, kc)
        n_new = decay[..., None] * nvec + jnp.einsum('bhs,bhsk->bhk', w_s, kc)
        return (c_new, n_new, m_new), h

    xs = tuple(to_chunks(a) for a in (q, k, v, log_i, log_f))
    state, h = lax.scan(step, state, xs)
    h = jnp.moveaxis(h, 0, 2).reshape(bsz, nh, seqlen, dh)
    return h, state


def zero_mlstm_state(bsz):
    return (jnp.zeros((bsz, N_MLSTM_HEADS, MLSTM_HEAD_DIM, MLSTM_HEAD_DIM), jnp.float32),
            jnp.zeros((bsz, N_MLSTM_HEADS, MLSTM_HEAD_DIM), jnp.float32),
            jnp.zeros((bsz, N_MLSTM_HEADS), jnp.float32))


def even_proj(xm, w_in, conv_qk, b_igate, b_fgate):
    bsz, seqlen, _ = xm.shape
    proj = xm @ w_in
    q, k, v, o, z_m, gates, u_p, z_p = jnp.split(proj, EVEN_SPLITS, axis=-1)
    qk = jax.nn.silu(dwconv_centered(jnp.concatenate([q, k], -1), conv_qk))
    q, k = jnp.split(qk, 2, axis=-1)

    def heads(a):
        return a.reshape(bsz, seqlen, N_MLSTM_HEADS, MLSTM_HEAD_DIM).transpose(0, 2, 1, 3)

    q, k, v = heads(q), heads(k) * (MLSTM_HEAD_DIM ** -0.5), heads(v)
    gates = gates.astype(jnp.float32).reshape(bsz, seqlen, 2, N_DIR, N_MLSTM_HEADS)
    log_i = (gates[:, :, 0] + b_igate).transpose(2, 0, 3, 1)
    log_f = jax.nn.log_sigmoid(gates[:, :, 1] + b_fgate).transpose(2, 0, 3, 1)
    return q, k, v, o, z_m, log_i, log_f, u_p, z_p


def multiscale_pool(u, row_len):
    bsz, seqlen, _ = u.shape
    rows = seqlen // row_len
    ug = u.astype(jnp.float32).reshape(bsz, rows, row_len, N_POOL_GROUPS, POOL_GROUP_DIM)
    cs = jnp.pad(jnp.cumsum(ug, axis=2), ((0, 0), (0, 0), (1, 0), (0, 0), (0, 0)))
    pos = jnp.arange(row_len)
    outs = []
    for g, w in enumerate(POOL_WINDOWS):
        lo = jnp.maximum(pos - w // 2, 0)
        hi = jnp.minimum(pos + (w - 1 - w // 2), row_len - 1)
        csg = cs[:, :, :, g, :]
        s = jnp.take(csg, hi + 1, axis=2) - jnp.take(csg, lo, axis=2)
        outs.append(s / (hi - lo + 1).astype(jnp.float32)[:, None])
    pooled = jnp.stack(outs, axis=3)
    return (pooled - ug).reshape(bsz, seqlen, N_POOL_GROUPS, POOL_GROUP_DIM)


def even_out(h, o, z_m, u_p, z_p, row_len, mh_norm_g, pool_w, pool_scale):
    bsz, nh, seqlen, dh = h.shape
    h = jnp.moveaxis(h, 1, 2) * jax.nn.sigmoid(o.astype(jnp.float32)).reshape(bsz, seqlen, nh, dh)
    h = _normalize(h).reshape(bsz, seqlen, D_MLSTM) * mh_norm_g
    y_m = h * jax.nn.silu(z_m.astype(jnp.float32))
    r = multiscale_pool(u_p, row_len)
    y_p = jnp.einsum('blgc,gcd->blgd', r, pool_w.astype(jnp.float32)).reshape(bsz, seqlen, D_POOL)
    y_p = y_p * pool_scale * jax.nn.silu(z_p.astype(jnp.float32))
    return jnp.concatenate([y_m, y_p], axis=-1).astype(u_p.dtype)


def sgu_mixer(xm, w_in, ln_g, ln_b, w_sp, b_sp):
    bsz, seqlen, _ = xm.shape
    u, v, z = jnp.split(xm @ w_in, 3, axis=-1)
    v = layer_norm(v, ln_g, ln_b)
    nc = seqlen // SGU_CHUNK
    vh = v.reshape(bsz, nc, SGU_CHUNK, N_SGU_HEADS, SGU_HEAD_DIM)
    s = jnp.einsum('hts,bnshc->bnthc', w_sp, vh) + b_sp.T[None, None, :, :, None]
    return u * s.reshape(bsz, seqlen, D_SGU) * jax.nn.silu(z)


def setup_inputs(seed: int = 0) -> dict:
    key = jax.random.key(seed)
    ks = jax.random.split(key, 24)

    def nrm(k, shape, s):
        return jax.random.normal(k, shape, jnp.float32) * s

    d = D_MODEL
    fgate_base = jnp.linspace(3.0, 6.0, N_MLSTM_HEADS, dtype=jnp.float32)
    return {
        "x": nrm(ks[0], (BATCH, SEQ, d), 1.0),
        "c": nrm(ks[1], (BATCH, d), 1.0),
        "ctx": nrm(ks[2], (BATCH, CTX_LEN, d), 1.0),
        "c_ctx": nrm(ks[3], (d,), 1.0),
        "ada_w": nrm(ks[4], (DEPTH, d, 3 * d), 0.5 * d ** -0.5),
        "ada_b": nrm(ks[5], (DEPTH, 3 * d), 0.02),
        "post_ln_g": 1.0 + nrm(ks[6], (DEPTH, d), 0.05),
        "post_ln_b": nrm(ks[7], (DEPTH, d), 0.02),
        "w_in_even": nrm(ks[8], (N_EVEN, d, N_IN_EVEN), d ** -0.5),
        "conv_qk": nrm(ks[9], (N_EVEN, QK_CONV, 2 * D_MLSTM), QK_CONV ** -0.5),
        "b_igate": nrm(ks[10], (N_EVEN, N_DIR, N_MLSTM_HEADS), 0.1),
        "b_fgate": fgate_base + nrm(ks[11], (N_EVEN, N_DIR, N_MLSTM_HEADS), 0.1),
        "mh_norm_g": 1.0 + nrm(ks[12], (N_EVEN, D_MLSTM), 0.05),
        "pool_w": nrm(ks[13], (N_EVEN, N_POOL_GROUPS, POOL_GROUP_DIM, POOL_GROUP_DIM), POOL_GROUP_DIM ** -0.5),
        "pool_scale": 1.0 + nrm(ks[14], (N_EVEN, D_POOL), 0.1),
        "w_out_even": nrm(ks[15], (N_EVEN, D_MLSTM + D_POOL, d), DEEPNORM_BETA * (D_MLSTM + D_POOL) ** -0.5),
        "w_in_odd": nrm(ks[16], (N_ODD, d, N_IN_ODD), d ** -0.5),
        "sgu_ln_g": 1.0 + nrm(ks[17], (N_ODD, D_SGU), 0.05),
        "sgu_ln_b": nrm(ks[18], (N_ODD, D_SGU), 0.02),
        "w_sp": nrm(ks[19], (N_ODD, N_SGU_HEADS, SGU_CHUNK, SGU_CHUNK), SGU_CHUNK ** -0.5),
        "b_sp": 1.0 + nrm(ks[20], (N_ODD, N_SGU_HEADS, SGU_CHUNK), 0.1),
        "w_out_odd": nrm(ks[21], (N_ODD, D_SGU, d), DEEPNORM_BETA * D_SGU ** -0.5),
    }


def reference(x, c, ctx, c_ctx, ada_w, ada_b, post_ln_g, post_ln_b, w_in_even, conv_qk, b_igate,
              b_fgate, mh_norm_g, pool_w, pool_scale, w_out_even, w_in_odd, sgu_ln_g, sgu_ln_b,
              w_sp, b_sp, w_out_odd):
    x_lat, x_ctx = x, ctx
    bsz = x.shape[0]
    for layer in range(DEPTH):
        last = layer == DEPTH - 1
        j = layer // 2
        sh_l, sc_l, g_l = ada_params(c, ada_w[layer], ada_b[layer])
        sh_l, sc_l, g_l = sh_l[:, None], sc_l[:, None], g_l[:, None]
        sh_c, sc_c, g_c = ada_params(c_ctx, ada_w[layer], ada_b[layer])
        xm_l = x_lat * (1.0 + sc_l) + sh_l
        xm_c = x_ctx * (1.0 + sc_c) + sh_c
        if layer % 2 == 0:
            ql, kl, vl, ol, zml, lil, lfl, upl, zpl = even_proj(xm_l, w_in_even[j], conv_qk[j], b_igate[j], b_fgate[j])
            qc, kc, vc, oc, zmc, lic, lfc, upc, zpc = even_proj(xm_c, w_in_even[j], conv_qk[j], b_igate[j], b_fgate[j])
            flip = lambda a: jnp.flip(a, axis=2)
            zero = zero_mlstm_state(bsz)
            hc_f, st_f = mlstm_scan(qc, kc, vc, lic[0], lfc[0], zero)
            hl_f, _ = mlstm_scan(ql, kl, vl, lil[0], lfl[0], st_f)
            hc_b, st_b = mlstm_scan(flip(qc), flip(kc), flip(vc), flip(lic[1]), flip(lfc[1]), zero)
            hl_b, _ = mlstm_scan(flip(ql), flip(kl), flip(vl), flip(lil[1]), flip(lfl[1]), st_b)
            y_l = even_out(hl_f + flip(hl_b), ol, zml, upl, zpl, GRID_W, mh_norm_g[j], pool_w[j], pool_scale[j])
            x_lat_new = layer_norm(DEEPNORM_ALPHA * x_lat + g_l * (y_l @ w_out_even[j]), post_ln_g[layer], post_ln_b[layer])
            if not last:
                y_c = even_out(hc_f + flip(hc_b), oc, zmc, upc, zpc, x_ctx.shape[1], mh_norm_g[j], pool_w[j], pool_scale[j])
                x_ctx = layer_norm(DEEPNORM_ALPHA * x_ctx + g_c * (y_c @ w_out_even[j]), post_ln_g[layer], post_ln_b[layer])
            x_lat = x_lat_new
        else:
            y_l = sgu_mixer(xm_l, w_in_odd[j], sgu_ln_g[j], sgu_ln_b[j], w_sp[j], b_sp[j])
            x_lat = layer_norm(DEEPNORM_ALPHA * x_lat + g_l * (y_l @ w_out_odd[j]), post_ln_g[layer], post_ln_b[layer])
            if not last:
                y_c = sgu_mixer(xm_c, w_in_odd[j], sgu_ln_g[j], sgu_ln_b[j], w_sp[j], b_sp[j])
                x_ctx = layer_norm(DEEPNORM_ALPHA * x_ctx + g_c * (y_c @ w_out_odd[j]), post_ln_g[layer], post_ln_b[layer])
    return x_lat
```

```cpp
#include <hip/hip_runtime.h>
#include <hip/hip_cooperative_groups.h>
#include <cstdio>
#include <cstdint>
namespace cg = cooperative_groups;

#define LAS __attribute__((address_space(3)))
typedef unsigned short bf16_t;
typedef short bf16x8 __attribute__((ext_vector_type(8)));
typedef float f32x4 __attribute__((ext_vector_type(4)));
typedef unsigned u32x4 __attribute__((ext_vector_type(4)));
typedef unsigned u32x2 __attribute__((ext_vector_type(2)));

constexpr size_t OFF_MODP  = 0;
constexpr size_t OFF_MOD   = OFF_MODP + 8ull * 2 * 5 * 6144 * 4;
constexpr size_t OFF_GATES = OFF_MOD + 2ull * 5 * 6144 * 4;
constexpr size_t OFF_GA    = OFF_GATES + 9216ull * 16 * 4;
constexpr size_t OFF_GP    = OFF_GA + 8ull * 9216 * 4;
constexpr size_t OFF_GB    = OFF_GP + 8ull * 9216 * 4;
constexpr size_t OFF_BL    = OFF_GB + 8ull * 9216 * 4;
constexpr size_t OFF_PX    = OFF_BL + 8ull * 144 * 4 + 512;
constexpr size_t OFF_KSUM  = OFF_PX + 8ull * 144 * 4 + 512;
constexpr size_t OFF_GAM   = OFF_KSUM + 2ull * 144 * 4 * 256 * 4;
constexpr size_t OFF_WINE  = (OFF_GAM + 8ull * 8192 * 4 + 4095) & ~4095ull;
constexpr size_t OFF_WOUTE = OFF_WINE + 7168ull * 2048 * 2;
constexpr size_t OFF_WINO  = OFF_WOUTE + 2048ull * 2048 * 2;
constexpr size_t OFF_WOUTO = OFF_WINO + 6144ull * 2048 * 2;
constexpr size_t OFF_POOLW = OFF_WOUTO + 2048ull * 2048 * 2;
constexpr size_t OFF_WSP   = OFF_POOLW + 4ull * 256 * 256 * 2;
constexpr size_t OFF_XM    = OFF_WSP + 8ull * 128 * 128 * 2;
constexpr size_t OFF_PROJ  = OFF_XM + 9216ull * 2048 * 2;
constexpr size_t OFF_QK    = OFF_PROJ + 9216ull * 7168 * 2;
constexpr size_t OFF_H     = OFF_QK + 9216ull * 2048 * 2;
constexpr size_t OFF_VT    = OFF_H + 2ull * 8192 * 1024 * 4;
constexpr size_t OFF_R     = OFF_VT + 144ull * 4 * 256 * 64 * 2;
constexpr size_t OFF_BAR   = OFF_R + 8192ull * 1024 * 2;
constexpr size_t OFF_RSTAT = OFF_BAR + 16384;
constexpr size_t OFF_RS2   = OFF_RSTAT + 8192ull * 16 * 4;
constexpr size_t WS_END    = OFF_RS2 + 8192ull * 64 * 4;

struct Params {
    const float *x, *c, *ctx, *cctx, *ada_w, *ada_b, *pln_g, *pln_b, *w_in_even, *conv_qk, *b_ig, *b_fg, *mh_g, *pool_w, *pool_scale,
        *w_out_even, *w_in_odd, *sgu_g, *sgu_b, *w_sp, *b_sp, *w_out_odd;
    float* out; unsigned char* ws;
};

__device__ __forceinline__ unsigned cvt_pk_bf16(float lo, float hi) { unsigned r; asm volatile("v_cvt_pk_bf16_f32 %0, %1, %2" : "=v"(r) : "v"(lo), "v"(hi)); return r; }
__device__ __forceinline__ float bflo(unsigned w) { return __uint_as_float(w << 16); }
__device__ __forceinline__ float bfhi(unsigned w) { return __uint_as_float(w & 0xffff0000u); }
__device__ __forceinline__ float bf1(bf16_t v) { return __uint_as_float(((unsigned)v) << 16); }
__device__ __forceinline__ bf16_t f2bf(float f) { unsigned u = __float_as_uint(f); return (bf16_t)((u + 0x7fffu + ((u >> 16) & 1u)) >> 16); }
__device__ __forceinline__ float silu_f(float x) { return x * __builtin_amdgcn_rcpf(1.f + __expf(-x)); }
__device__ __forceinline__ float sigm_f(float x) { return __builtin_amdgcn_rcpf(1.f + __expf(-x)); }
__device__ __forceinline__ void unpack8(const u32x4 w, float* f) { f[0] = bflo(w[0]); f[1] = bfhi(w[0]); f[2] = bflo(w[1]); f[3] = bfhi(w[1]); f[4] = bflo(w[2]); f[5] = bfhi(w[2]); f[6] = bflo(w[3]); f[7] = bfhi(w[3]); }
__device__ __forceinline__ u32x4 pack8(const float* f) { u32x4 w; w[0] = cvt_pk_bf16(f[0], f[1]); w[1] = cvt_pk_bf16(f[2], f[3]); w[2] = cvt_pk_bf16(f[4], f[5]); w[3] = cvt_pk_bf16(f[6], f[7]); return w; }
__device__ __forceinline__ bf16x8 ldfrag(const LAS bf16_t* base, int stride, int row, int kc) { return *(const LAS bf16x8*)(base + row * stride + kc); }
#define MFMA16(a, b, c) __builtin_amdgcn_mfma_f32_16x16x32_bf16(a, b, c, 0, 0, 0)
template <int CTRL> __device__ __forceinline__ float dpp_mov(float x) { return __builtin_bit_cast(float, __builtin_amdgcn_update_dpp(0, __builtin_bit_cast(int, x), CTRL, 0xf, 0xf, false)); }
__device__ __forceinline__ float rows_sum(float x) {
    { auto r = __builtin_amdgcn_permlane16_swap(__builtin_bit_cast(unsigned, x), __builtin_bit_cast(unsigned, x), false, false); x = __builtin_bit_cast(float, (unsigned)r[0]) + __builtin_bit_cast(float, (unsigned)r[1]); }
    { auto r = __builtin_amdgcn_permlane32_swap(__builtin_bit_cast(unsigned, x), __builtin_bit_cast(unsigned, x), false, false); x = __builtin_bit_cast(float, (unsigned)r[0]) + __builtin_bit_cast(float, (unsigned)r[1]); }
    return x;
}
__device__ __forceinline__ float wave_sum(float x) {
    x += dpp_mov<0xB1>(x);
    x += dpp_mov<0x4E>(x);
    x += dpp_mov<0x141>(x);
    x += dpp_mov<0x140>(x);
    const int xi = __builtin_bit_cast(int, x);
    const float r0 = __builtin_bit_cast(float, __builtin_amdgcn_readlane(xi, 0)), r1 = __builtin_bit_cast(float, __builtin_amdgcn_readlane(xi, 16));
    const float r2 = __builtin_bit_cast(float, __builtin_amdgcn_readlane(xi, 32)), r3 = __builtin_bit_cast(float, __builtin_amdgcn_readlane(xi, 48));
    return (r0 + r1) + (r2 + r3);
}

#define XB_TMO      128
#define XB_XCNT(j)  (256  + 64 * (j))
#define XB_XSUB(j)  (1280 + 64 * (j))
#define XB_XGEN(j)  (2304 + 64 * (j))
#define XB_TOP      3328
#define XB_TOPGEN   3392
#define XCD_BAR_WORDS 3456
#define XB_SPIN_CAP (1u << 18)
__device__ __forceinline__ unsigned xb_ld(unsigned* p)              { return __hip_atomic_load(p, __ATOMIC_RELAXED, __HIP_MEMORY_SCOPE_AGENT); }
__device__ __forceinline__ unsigned xb_add(unsigned* p, unsigned v) { return __hip_atomic_fetch_add(p, v, __ATOMIC_RELAXED, __HIP_MEMORY_SCOPE_AGENT); }
__device__ __forceinline__ unsigned xb_xcc_id() { return (unsigned)__builtin_amdgcn_s_getreg((3 << 11) | 20) & 0xFu; }
#define XB_SPIN(cond, bar) do { unsigned _sp = 0; while (cond) { __builtin_amdgcn_s_sleep(1); \
    if ((++_sp & 255u) == 0u) { if (xb_ld(&(bar)[XB_TMO])) break; if (_sp > XB_SPIN_CAP) { atomicAdd(&(bar)[XB_TMO], 1u); break; } } } } while (0)

struct XcdBarrier {
    unsigned* bar; unsigned x;
    volatile LAS unsigned* st;
};

__device__ __forceinline__ XcdBarrier xcd_barrier_post(unsigned* bar, volatile LAS unsigned* st) {
    XcdBarrier b; b.bar = bar; b.x = xb_xcc_id(); b.st = st;
    if (threadIdx.x == 0) (void)xb_add(&bar[XB_XCNT(b.x)], 1u);
    return b;
}
__device__ __forceinline__ void xcd_barrier_complete(unsigned* bar, unsigned x, unsigned& nloc, unsigned& nx) {
    const unsigned G = gridDim.x * gridDim.y * gridDim.z;
    unsigned sum, cnt, mine, sp = 0u;
    for (;;) {
        sum = 0u; cnt = 0u; mine = 0u;
#pragma unroll
        for (unsigned j = 0; j < 16; ++j) { const unsigned c = xb_ld(&bar[XB_XCNT(j)]); sum += c; cnt += (c > 0u) ? 1u : 0u; mine = (j == x) ? c : mine; }
        if (sum == G) break;
        __builtin_amdgcn_s_sleep(1);
        if ((++sp & 255u) == 0u) { if (xb_ld(&bar[XB_TMO])) break; if (sp > XB_SPIN_CAP) { atomicAdd(&bar[XB_TMO], 1u); break; } }
    }
    nloc = mine > 0u ? mine : 1u; nx = cnt > 0u ? cnt : 1u;
}

__device__ __forceinline__ void xcd_barrier(const XcdBarrier& b) {
    asm volatile("s_waitcnt vmcnt(0)" ::: "memory");
    __syncthreads();
    if (threadIdx.x == 0) {
        unsigned* bar = b.bar;
        __builtin_amdgcn_s_waitcnt(0);
        unsigned nloc = b.st[0], nx = b.st[1];
        if (nloc == 0u) { xcd_barrier_complete(bar, b.x, nloc, nx); b.st[0] = nloc; b.st[1] = nx; }
        const unsigned old = xb_add(&bar[XB_XSUB(b.x)], 1u);
        const unsigned gen = old / nloc;
        if (old + 1u == (gen + 1u) * nloc) {
            __builtin_amdgcn_fence(__ATOMIC_RELEASE, "agent");
            asm volatile("s_waitcnt vmcnt(0)" ::: "memory");
            const unsigned og = xb_add(&bar[XB_TOP], 1u);
            const unsigned tg = og / nx;
            if (og + 1u == (tg + 1u) * nx) xb_add(&bar[XB_TOPGEN], 1u);
            else XB_SPIN(xb_ld(&bar[XB_TOPGEN]) == tg, bar);
            __builtin_amdgcn_fence(__ATOMIC_ACQUIRE, "agent");
            xb_add(&bar[XB_XGEN(b.x)], 1u);
            asm volatile("s_waitcnt vmcnt(0)" ::: "memory");
        } else {
            XB_SPIN(xb_ld(&bar[XB_XGEN(b.x)]) == gen, bar);
            __builtin_amdgcn_fence(__ATOMIC_ACQUIRE, "agent");
            asm volatile("s_waitcnt vmcnt(0)" ::: "memory");
        }
    }
    __syncthreads();
}

#ifndef PG8_SP2
#define PG8_SP2 1
#endif
#ifndef PG8_ALIGN
#define PG8_ALIGN 1
#endif
namespace pg8 {
constexpr int BM = 256, BK = 64, HALF = 128, HTB = HALF * BK * 2, STAGE_BYTES = 8 * HTB, NXCD = 8, WGM = 8;
__device__ __forceinline__ int lds_byte(int r, int c) { const int st = (r >> 4) * 2 + (c >> 5), rr = r & 15, cc = c & 31, ob = rr * 64 + cc * 2; return st * 1024 + (ob ^ (((ob >> 9) & 1) << 5)); }
__device__ __forceinline__ void stage_rc(int b, int& R, int& C) { const int st = b / 1024, sb = b % 1024, swz = sb ^ (((sb >> 9) & 1) << 5); R = (st >> 1) * 16 + swz / 64; C = (st & 1) * 32 + (swz % 64) / 2; }
__device__ __forceinline__ int perm32(int rho) { const int n = rho >> 4, i = rho & 15; return 8 * (i >> 2) + 4 * n + (i & 3); }
struct Unit { int pm, pn; };
struct Gemm { const bf16_t* A; const bf16_t* Bt; int lda, ldb, K, acol; int align; };
struct Sched {
    int mode, nM, nN, nwg, G, c;
    __device__ __forceinline__ bool next(int i, Unit& u) const {
        const int L = i * G + c;
        if (mode == 2) { if (L >= 128) return false; u.pm = L & 31; u.pn = L >> 5; return true; }
        if (L >= nwg + (mode == 1 ? 48 : 0)) return false;
        if (L >= nwg) { const int e = L - nwg; u.pm = 32 + (e & 3); u.pn = e >> 2; return true; }
        int wgid = L; { const int q = nwg / NXCD, r = nwg % NXCD, xcd = wgid % NXCD, off = wgid / NXCD; wgid = (xcd < r ? xcd * (q + 1) : r * (q + 1) + (xcd - r) * q) + off; }
        const int nig = WGM * nN, gid = wgid / nig, fm = gid * WGM, gsz = (nM - fm) < WGM ? (nM - fm) : WGM;
        u.pm = fm + ((wgid % nig) % gsz); u.pn = (wgid % nig) / gsz; return true;
    }
};
struct Epi {
    int mode;
    bf16_t* O; int ldc;
    bf16_t* O2;
    float* rs2;
    const bf16_t* zsrc; const float* pscale;
    const float* xres; const float* gate; float* out;
    const float* lng; const float* lnb; const float* mod1; bf16_t* xm1; float* rstat; const XcdBarrier* xb;
    __device__ __forceinline__ void fused_ln(f32x4 (&acc)[2][2][4][2], const Unit& u, int wr, int wc, int fr, int fq, LAS unsigned char* lds) const {
        asm volatile("" : "+v"(fr), "+v"(fq));
        const int tid = threadIdx.x;
        LAS float* part = (LAS float*)lds;
        LAS float* st = (LAS float*)(lds + 8192);
        const int row0 = u.pm * BM + wr * 64 + fr, col0 = u.pn * BM + wc * 32 + 8 * fq; const int b = (u.pm * BM) >> 11;
        { f32x4 gv[2][2];
#pragma unroll
          for (int bj = 0; bj < 2; ++bj)
#pragma unroll
              for (int n = 0; n < 2; ++n) gv[bj][n] = *(const f32x4*)(gate + (size_t)b * 6144 + 4096 + col0 + bj * HALF + n * 4);
#pragma unroll
          for (int ai = 0; ai < 2; ++ai)
#pragma unroll
              for (int m = 0; m < 4; ++m) { const size_t off = (size_t)(row0 + ai * HALF + m * 16) * 2048 + col0; float s = 0.f, q = 0.f;
#pragma unroll
                  for (int bj = 0; bj < 2; ++bj)
#pragma unroll
                      for (int n = 0; n < 2; ++n) { const f32x4 xr = __builtin_nontemporal_load((const f32x4*)(xres + off + bj * HALF + n * 4));
                          const f32x4 t = xr * 1.41421356237f + gv[bj][n] * acc[ai][bj][m][n]; acc[ai][bj][m][n] = t;
                          s += (t[0] + t[1]) + (t[2] + t[3]); q += (t[0] * t[0] + t[1] * t[1]) + (t[2] * t[2] + t[3] * t[3]); }
                  s = rows_sum(s); q = rows_sum(q);
                  if (fq == 0) { const int rl = ai * HALF + wr * 64 + m * 16 + fr; part[(wc * 256 + rl) * 2] = s; part[(wc * 256 + rl) * 2 + 1] = q; }
                  if (m & 1) asm volatile("" ::: "memory"); } }
        __syncthreads();
        if (tid < 256) { const float s = (part[tid * 2] + part[(256 + tid) * 2]) + (part[(512 + tid) * 2] + part[(768 + tid) * 2]);
            const float q = (part[tid * 2 + 1] + part[(256 + tid) * 2 + 1]) + (part[(512 + tid) * 2 + 1] + part[(768 + tid) * 2 + 1]);
            float* dst = rstat + ((size_t)(u.pm * BM + tid) * 8 + u.pn) * 2; dst[0] = s; dst[1] = q; }
        xcd_barrier(*xb);
        if (tid < 256) { const float* src = rstat + (size_t)(u.pm * BM + tid) * 16; float s = 0.f, q = 0.f;
#pragma unroll
            for (int j = 0; j < 8; ++j) { s += src[2 * j]; q += src[2 * j + 1]; }
            const float mu = s * (1.f / 2048.f); const float var = fmaxf(q * (1.f / 2048.f) - mu * mu, 0.f);
            st[tid * 2] = mu; st[tid * 2 + 1] = rsqrtf(var + 1e-5f); }
        __syncthreads();
        { f32x4 lg[2][2], lb[2][2];
#pragma unroll
          for (int bj = 0; bj < 2; ++bj)
#pragma unroll
              for (int n = 0; n < 2; ++n) { lg[bj][n] = *(const f32x4*)(lng + col0 + bj * HALF + n * 4); lb[bj][n] = *(const f32x4*)(lnb + col0 + bj * HALF + n * 4); }
          f32x4 msh[2][2], msc[2][2];
#pragma unroll
          for (int bj = 0; bj < 2; ++bj)
#pragma unroll
              for (int n = 0; n < 2; ++n) { if (xm1) { const float* mp = mod1 + (size_t)b * 6144 + col0 + bj * HALF + n * 4; msh[bj][n] = *(const f32x4*)mp; msc[bj][n] = *(const f32x4*)(mp + 2048) + 1.f; }
                  else { msh[bj][n] = (f32x4){0.f, 0.f, 0.f, 0.f}; msc[bj][n] = msh[bj][n]; } }
#pragma unroll
          for (int ai = 0; ai < 2; ++ai)
#pragma unroll
              for (int m = 0; m < 4; ++m) { const int rl = ai * HALF + wr * 64 + m * 16 + fr; const float mu = st[rl * 2], rs = st[rl * 2 + 1];
                  const size_t off = (size_t)(row0 + ai * HALF + m * 16) * 2048 + col0;
#pragma unroll
                  for (int bj = 0; bj < 2; ++bj) { f32x4 y[2];
#pragma unroll
                      for (int n = 0; n < 2; ++n) { y[n] = (acc[ai][bj][m][n] - mu) * rs * lg[bj][n] + lb[bj][n]; *(f32x4*)(out + off + bj * HALF + n * 4) = y[n]; }
                      if (xm1) { const f32x4 x0 = y[0] * msc[bj][0] + msh[bj][0], x1 = y[1] * msc[bj][1] + msh[bj][1];
                          u32x4 w; w[0] = cvt_pk_bf16(x0[0], x0[1]); w[1] = cvt_pk_bf16(x0[2], x0[3]); w[2] = cvt_pk_bf16(x1[0], x1[1]); w[3] = cvt_pk_bf16(x1[2], x1[3]);
                          *(u32x4*)(xm1 + off + bj * HALF) = w; } }
                  asm volatile("" ::: "memory"); } }
    }
    __device__ __forceinline__ void operator()(const f32x4 (&acc)[2][2][4][2], const Unit& u, int wr, int wc, int fr, int fq) const {
        asm volatile("" : "+v"(fr), "+v"(fq));
        if (mode == 0) {
            const int row0 = u.pm * BM + wr * 64 + fr, col0 = u.pn * BM + wc * 32 + 8 * fq;
#pragma unroll
            for (int ai = 0; ai < 2; ++ai)
#pragma unroll
                for (int m = 0; m < 4; ++m) { bf16_t* rowp = O + (size_t)(row0 + ai * HALF + m * 16) * ldc + col0; float ss = 0.f, qq = 0.f;
#pragma unroll
                    for (int bj = 0; bj < 2; ++bj) { const f32x4 v0 = acc[ai][bj][m][0], v1 = acc[ai][bj][m][1];
                        u32x4 w; w[0] = cvt_pk_bf16(v0[0], v0[1]); w[1] = cvt_pk_bf16(v0[2], v0[3]); w[2] = cvt_pk_bf16(v1[0], v1[1]); w[3] = cvt_pk_bf16(v1[2], v1[3]);
                        *(u32x4*)(rowp + bj * HALF) = w;
                        ss += ((v0[0] + v0[1]) + (v0[2] + v0[3])) + ((v1[0] + v1[1]) + (v1[2] + v1[3]));
                        qq += ((v0[0] * v0[0] + v0[1] * v0[1]) + (v0[2] * v0[2] + v0[3] * v0[3])) + ((v1[0] * v1[0] + v1[1] * v1[1]) + (v1[2] * v1[2] + v1[3] * v1[3])); }
                    if (rs2 && (u.pn >> 3) == 1) { ss += __shfl_xor(ss, 16); qq += __shfl_xor(qq, 16); ss += __shfl_xor(ss, 32); qq += __shfl_xor(qq, 32);
                        if (fq == 0) { float* d = rs2 + ((size_t)(row0 + ai * HALF + m * 16) * 32 + (u.pn - 8) * 4 + wc) * 2; d[0] = ss; d[1] = qq; } } }
        } else if (mode == 3) {
            const int row0 = u.pm * BM + wr * 64 + fr;
            if (u.pn < 16) { const int col0 = u.pn * 128 + wc * 32 + 8 * fq;
#pragma unroll
                for (int ai = 0; ai < 2; ++ai)
#pragma unroll
                    for (int m = 0; m < 4; ++m) { const f32x4 u0 = acc[ai][0][m][0], u1 = acc[ai][0][m][1], z0 = acc[ai][1][m][0], z1 = acc[ai][1][m][1]; float o[8];
#pragma unroll
                        for (int q = 0; q < 4; ++q) { o[q] = u0[q] * silu_f(z0[q]); o[4 + q] = u1[q] * silu_f(z1[q]); }
                        *(u32x4*)(O + (size_t)(row0 + ai * HALF + m * 16) * 2048 + col0) = pack8(o); }
            } else { const int col0 = (u.pn - 16) * BM + wc * 32 + 8 * fq;
#pragma unroll
                for (int ai = 0; ai < 2; ++ai)
#pragma unroll
                    for (int m = 0; m < 4; ++m) { bf16_t* rowp = O2 + (size_t)(row0 + ai * HALF + m * 16) * 2048 + col0; float ss = 0.f, qq = 0.f;
#pragma unroll
                        for (int bj = 0; bj < 2; ++bj) { const f32x4 v0 = acc[ai][bj][m][0], v1 = acc[ai][bj][m][1];
                            u32x4 w; w[0] = cvt_pk_bf16(v0[0], v0[1]); w[1] = cvt_pk_bf16(v0[2], v0[3]); w[2] = cvt_pk_bf16(v1[0], v1[1]); w[3] = cvt_pk_bf16(v1[2], v1[3]);
                            *(u32x4*)(rowp + bj * HALF) = w;
                            ss += ((v0[0] + v0[1]) + (v0[2] + v0[3])) + ((v1[0] + v1[1]) + (v1[2] + v1[3]));
                            qq += ((v0[0] * v0[0] + v0[1] * v0[1]) + (v0[2] * v0[2] + v0[3] * v0[3])) + ((v1[0] * v1[0] + v1[1] * v1[1]) + (v1[2] * v1[2] + v1[3] * v1[3])); }
                        ss = rows_sum(ss); qq = rows_sum(qq);
                        if (fq == 0) { float* d = rs2 + ((size_t)(row0 + ai * HALF + m * 16) * 32 + (u.pn - 16) * 4 + wc) * 2; d[0] = ss; d[1] = qq; } } }
        } else if (mode == 1) {
            const int g = u.pn; const int row0 = u.pm * BM + wr * 64 + fr, cg0 = wc * 32 + 8 * fq;
#pragma unroll
            for (int bj = 0; bj < 2; ++bj) { const int cg = cg0 + bj * HALF;
                const f32x4 ps0 = *(const f32x4*)(pscale + g * 256 + cg), ps1 = *(const f32x4*)(pscale + g * 256 + cg + 4);
#pragma unroll
                for (int ai = 0; ai < 2; ++ai)
#pragma unroll
                    for (int m = 0; m < 4; ++m) { const size_t row = (size_t)(row0 + ai * HALF + m * 16);
                        const u32x4 zw = *(const u32x4*)(zsrc + row * 7168 + 6144 + g * 256 + cg); float z[8]; unpack8(zw, z);
                        const f32x4 v0 = acc[ai][bj][m][0], v1 = acc[ai][bj][m][1]; float o[8];
#pragma unroll
                        for (int q = 0; q < 4; ++q) { o[q] = v0[q] * ps0[q] * silu_f(z[q]); o[4 + q] = v1[q] * ps1[q] * silu_f(z[4 + q]); }
                        *(u32x4*)(O + row * 2048 + 1024 + g * 256 + cg) = pack8(o);
                        if (m == 3) asm volatile("" ::: "memory"); } }
        } else {
            const int row0 = u.pm * BM + wr * 64 + fr, col0 = u.pn * BM + wc * 32 + 8 * fq; const int b = (u.pm * BM) >> 11;
            f32x4 gv[2][2];
#pragma unroll
            for (int bj = 0; bj < 2; ++bj)
#pragma unroll
                for (int n = 0; n < 2; ++n) gv[bj][n] = *(const f32x4*)(gate + (size_t)b * 6144 + 4096 + col0 + bj * HALF + n * 4);
#pragma unroll
            for (int ai = 0; ai < 2; ++ai)
#pragma unroll
                for (int m = 0; m < 4; ++m) { const size_t off = (size_t)(row0 + ai * HALF + m * 16) * 2048 + col0;
#pragma unroll
                    for (int bj = 0; bj < 2; ++bj)
#pragma unroll
                        for (int n = 0; n < 2; ++n) { const f32x4 xr = *(const f32x4*)(xres + off + bj * HALF + n * 4);
                            *(f32x4*)(out + off + bj * HALF + n * 4) = xr * 1.41421356237f + gv[bj][n] * acc[ai][bj][m][n]; } }
        }
    }
};

__device__ __forceinline__ void gemm_phase(LAS unsigned char* lds, const Gemm g, const Sched& S, const Epi& E) {
    const int tid = threadIdx.x, wid = __builtin_amdgcn_readfirstlane(tid >> 6), lane = tid & 63, wr = wid >> 2, wc = wid & 3, fr = lane & 15, fq = lane >> 4;
    const int K = g.K, nt = K / BK; const bool perm = true;
    unsigned voffA[2], voffB[2];
#pragma unroll
    for (int i = 0; i < 2; ++i) { int R, C; stage_rc(tid * 16 + i * 8192, R, C); const int Rb = perm ? ((R & ~31) + perm32(R & 31)) : R;
        voffA[i] = (unsigned)(R * g.lda + C) * 2u; voffB[i] = (unsigned)(Rb * g.ldb + C) * 2u; }
    const size_t kstep = (size_t)(BK * 2);
    const size_t hstepA = (size_t)HALF * g.lda * 2, hstepB = (size_t)HALF * g.ldb * 2;
    const unsigned ldsw = (unsigned)wid * 1024u;
    const int aoff = lds_byte(wr * 64 + fr, fq * 8), boff = lds_byte(wc * 32 + fr, fq * 8);
#define PG8_SA(b, h) (((b) * 2 + (h)) * HTB)
#define PG8_SB(b, h) ((4 + (b) * 2 + (h)) * HTB)
#define PG8_STAGE(bufoff, gbase, voff) do { _Pragma("unroll") for (int _i = 0; _i < 2; ++_i) \
        __builtin_amdgcn_global_load_lds((const unsigned*)((const char*)(gbase) + (voff)[_i]), (LAS unsigned*)(lds + (bufoff) + ldsw + _i * 8192), 16, 0, 0); } while (0)
#define PG8_LDA(dst, b, h) do { _Pragma("unroll") for (int m = 0; m < 4; ++m) _Pragma("unroll") for (int k = 0; k < 2; ++k) dst[m][k] = *(const LAS bf16x8*)(lds + PG8_SA(b, h) + aoff + m * 2048 + k * 1024); } while (0)
#define PG8_LDB(dst, b, h) do { _Pragma("unroll") for (int n = 0; n < 2; ++n) _Pragma("unroll") for (int k = 0; k < 2; ++k) dst[n][k] = *(const LAS bf16x8*)(lds + PG8_SB(b, h) + boff + n * 2048 + k * 1024); } while (0)
#define PG8_MMA(ai, bj, At, Bt) do { __builtin_amdgcn_s_setprio(1); _Pragma("unroll") for (int m = 0; m < 4; ++m) _Pragma("unroll") for (int n = 0; n < 2; ++n) _Pragma("unroll") for (int k = 0; k < 2; ++k) \
        acc[ai][bj][m][n] = __builtin_amdgcn_mfma_f32_16x16x32_bf16(Bt[n][k], At[m][k], acc[ai][bj][m][n], 0, 0, 0); __builtin_amdgcn_s_setprio(0); } while (0)
#define PG8_WAIT_V(n) asm volatile("s_waitcnt vmcnt(" #n ")" ::: "memory")
#define PG8_WAIT_L(n) asm volatile("s_waitcnt lgkmcnt(" #n ")" ::: "memory")
#define PG8_BAR __builtin_amdgcn_s_barrier()
#define PG8_SCHED __builtin_amdgcn_sched_barrier(0)
#define PG8_APTR(u) ((const char*)g.A + ((size_t)(u).pm * BM * g.lda + (size_t)(u).pn * g.acol) * 2)
#define PG8_BPTR(u) ((const char*)g.Bt + (size_t)(u).pn * BM * g.ldb * 2)
    Unit cur, nxt; int ui = 0;
    if (!S.next(0, cur)) return;
    f32x4 acc[2][2][4][2];
#pragma unroll
    for (int a = 0; a < 2; ++a)
#pragma unroll
        for (int b = 0; b < 2; ++b)
#pragma unroll
            for (int m = 0; m < 4; ++m)
#pragma unroll
                for (int n = 0; n < 2; ++n) acc[a][b][m][n] = (f32x4){0.f, 0.f, 0.f, 0.f};
    bf16x8 At[4][2], B0[2][2], B1[2][2];
    const char* cA = PG8_APTR(cur); const char* cB = PG8_BPTR(cur);
#if PG8_SP2
    PG8_STAGE(PG8_SB(0, 0), cB, voffB); PG8_STAGE(PG8_SB(0, 1), cB + hstepB, voffB); PG8_STAGE(PG8_SA(0, 0), cA, voffA); PG8_STAGE(PG8_SA(0, 1), cA + hstepA, voffA);
    if (wr == 1) PG8_BAR;
    PG8_WAIT_V(2); PG8_BAR;
    PG8_STAGE(PG8_SB(1, 0), cB + kstep, voffB); PG8_STAGE(PG8_SA(1, 0), cA + kstep, voffA); PG8_STAGE(PG8_SB(1, 1), cB + hstepB + kstep, voffB);
    PG8_WAIT_V(6); PG8_BAR;
#else
    PG8_STAGE(PG8_SB(0, 0), cB, voffB); PG8_STAGE(PG8_SA(0, 0), cA, voffA); PG8_STAGE(PG8_SB(0, 1), cB + hstepB, voffB); PG8_STAGE(PG8_SA(0, 1), cA + hstepA, voffA);
    if (wr == 1) PG8_BAR;
    PG8_WAIT_V(4); PG8_BAR;
    PG8_STAGE(PG8_SB(1, 0), cB + kstep, voffB); PG8_STAGE(PG8_SA(1, 0), cA + kstep, voffA); PG8_STAGE(PG8_SB(1, 1), cB + hstepB + kstep, voffB);
    PG8_WAIT_V(6); PG8_BAR;
#endif
    for (;;) {
        const bool has_next = S.next(ui + 1, nxt);
        const char* nA = has_next ? PG8_APTR(nxt) : cA; const char* nB = has_next ? PG8_BPTR(nxt) : cB;
        for (int t = 0; t < nt; t += 2) {
            const bool last = (t == nt - 2);
            const char* a1 = cA + (size_t)(t + 1) * kstep;
            const char* a2 = last ? nA : cA + (size_t)(t + 2) * kstep; const char* b2 = last ? nB : cB + (size_t)(t + 2) * kstep;
            const char* a3 = a2 + kstep; const char* b3 = b2 + kstep;
#if PG8_SP2
            PG8_LDB(B0, 0, 0); PG8_LDB(B1, 0, 1); PG8_SCHED; PG8_LDA(At, 0, 0); PG8_STAGE(PG8_SA(1, 1), a1 + hstepA, voffA);
            PG8_WAIT_V(8); PG8_WAIT_L(0); PG8_BAR; PG8_MMA(0, 0, At, B0); PG8_MMA(0, 1, At, B1); PG8_BAR; PG8_SCHED;
            PG8_LDA(At, 0, 1); PG8_STAGE(PG8_SB(0, 0), b2, voffB); PG8_STAGE(PG8_SB(0, 1), b2 + hstepB, voffB); PG8_STAGE(PG8_SA(0, 0), a2, voffA);
            PG8_WAIT_V(8); PG8_WAIT_L(0); PG8_BAR; PG8_MMA(1, 0, At, B0); PG8_MMA(1, 1, At, B1); PG8_BAR; PG8_SCHED;
            PG8_LDB(B0, 1, 0); PG8_LDB(B1, 1, 1); PG8_SCHED; PG8_LDA(At, 1, 0); PG8_STAGE(PG8_SA(0, 1), a2 + hstepA, voffA);
            PG8_WAIT_V(8); PG8_WAIT_L(0); PG8_BAR; PG8_MMA(0, 0, At, B0); PG8_MMA(0, 1, At, B1); PG8_BAR; PG8_SCHED;
            PG8_LDA(At, 1, 1); PG8_STAGE(PG8_SB(1, 0), b3, voffB); PG8_STAGE(PG8_SB(1, 1), b3 + hstepB, voffB); PG8_STAGE(PG8_SA(1, 0), a3, voffA);
            PG8_WAIT_V(8); PG8_WAIT_L(0); PG8_BAR; PG8_MMA(1, 0, At, B0); PG8_MMA(1, 1, At, B1); PG8_BAR; PG8_SCHED;
#else
            PG8_LDB(B0, 0, 0); PG8_SCHED; PG8_LDA(At, 0, 0); PG8_STAGE(PG8_SA(1, 1), a1 + hstepA, voffA);
            PG8_WAIT_L(8); PG8_BAR; PG8_WAIT_L(0); PG8_MMA(0, 0, At, B0); PG8_BAR; PG8_SCHED;
            PG8_LDB(B1, 0, 1); PG8_STAGE(PG8_SB(0, 0), b2, voffB);
            PG8_BAR; PG8_WAIT_L(0); PG8_MMA(0, 1, At, B1); PG8_BAR;
            PG8_LDA(At, 0, 1); PG8_STAGE(PG8_SA(0, 0), a2, voffA);
            PG8_BAR; PG8_WAIT_L(0); PG8_MMA(1, 0, At, B0); PG8_BAR; PG8_SCHED;
            PG8_STAGE(PG8_SB(0, 1), b2 + hstepB, voffB);
            PG8_WAIT_V(6); PG8_BAR; PG8_MMA(1, 1, At, B1); PG8_BAR;
            PG8_LDB(B0, 1, 0); PG8_SCHED; PG8_LDA(At, 1, 0); PG8_STAGE(PG8_SA(0, 1), a2 + hstepA, voffA);
            PG8_WAIT_L(8); PG8_BAR; PG8_WAIT_L(0); PG8_MMA(0, 0, At, B0); PG8_BAR; PG8_SCHED;
            PG8_LDB(B1, 1, 1); PG8_STAGE(PG8_SB(1, 0), b3, voffB);
            PG8_BAR; PG8_WAIT_L(0); PG8_MMA(0, 1, At, B1); PG8_BAR;
            PG8_LDA(At, 1, 1); PG8_STAGE(PG8_SA(1, 0), a3, voffA);
            PG8_BAR; PG8_WAIT_L(0); PG8_MMA(1, 0, At, B0); PG8_BAR; PG8_SCHED;
            PG8_STAGE(PG8_SB(1, 1), b3 + hstepB, voffB);
            PG8_WAIT_V(6); PG8_BAR; PG8_MMA(1, 1, At, B1); PG8_BAR;
#endif
        }
        if (g.align && wr == 0) PG8_BAR;
        if (E.mode != 2) E(acc, cur, wr, wc, fr, fq);
        if (!has_next) break;
#pragma unroll
        for (int a = 0; a < 2; ++a)
#pragma unroll
            for (int b = 0; b < 2; ++b)
#pragma unroll
                for (int m = 0; m < 4; ++m)
#pragma unroll
                    for (int n = 0; n < 2; ++n) acc[a][b][m][n] = (f32x4){0.f, 0.f, 0.f, 0.f};
        cur = nxt; cA = nA; cB = nB; ++ui;
        if (g.align && wr == 1) PG8_BAR;
    }
    PG8_WAIT_V(0);
    if (!g.align && wr == 0) PG8_BAR;
    PG8_BAR;
    if (E.mode == 2) E.fused_ln(acc, cur, wr, wc, fr, fq, lds);
}
}

struct TrDesc { const float* src; bf16_t* dst; int ldsrc, lddst, k0, n0s, n0d; };
__device__ __forceinline__ TrDesc tr_desc(const Params& p, int set, int q) {
    TrDesc d; int kg;
    if (set == 0) {
        if (q < 896) { const int nt = q >> 3; kg = q & 7; d.src = p.w_in_even; d.ldsrc = 7184; d.n0d = nt * 64; d.n0s = d.n0d + (nt >= 80 ? 16 : 0); d.dst = (bf16_t*)(p.ws + OFF_WINE); d.lddst = 2048; }
        else if ((q -= 896) < 256) { const int nt = q >> 3; kg = q & 7; d.src = p.w_out_even; d.ldsrc = 2048; d.n0d = d.n0s = nt * 64; d.dst = (bf16_t*)(p.ws + OFF_WOUTE); d.lddst = 2048; }
        else { q -= 256; const int g = q >> 2, nt = q & 3; kg = 0; d.src = p.pool_w + g * 65536; d.ldsrc = 256; d.n0d = d.n0s = nt * 64; d.dst = (bf16_t*)(p.ws + OFF_POOLW) + g * 65536; d.lddst = 256; }
    } else {
        if (q < 768) { const int nt = q >> 3; kg = q & 7; d.src = p.w_in_odd; d.ldsrc = 6144; d.n0d = nt * 64; d.dst = (bf16_t*)(p.ws + OFF_WINO); d.lddst = 2048;
            const int pnp = nt >> 2, within = (nt & 3) * 64;
            d.n0s = pnp < 16 ? ((within >> 7) ? 4096 : 0) + pnp * 128 + (within & 127) : 2048 + (pnp - 16) * 256 + within; }
        else { q -= 768; const int nt = q >> 3; kg = q & 7; d.src = p.w_out_odd; d.ldsrc = 2048; d.n0d = d.n0s = nt * 64; d.dst = (bf16_t*)(p.ws + OFF_WOUTO); d.lddst = 2048; }
    }
    d.k0 = kg * 256; return d;
}
__device__ __forceinline__ void tr_loop(const Params& p, LAS unsigned char* lds, int set, int q0, int qend, int stride) {
    const int tid = threadIdx.x; LAS float* lf = (LAS float*)lds;
    const int kr = tid >> 4, c4 = tid & 15, n = tid >> 3, kseg = tid & 7;
    f32x4 v[8];
    int q = q0;
    if (q < qend) { const TrDesc d = tr_desc(p, set, q);
#pragma unroll
        for (int ps = 0; ps < 8; ++ps) v[ps] = __builtin_nontemporal_load((const f32x4*)(d.src + (size_t)(d.k0 + kr + 32 * ps) * d.ldsrc + d.n0s + c4 * 4)); }
    while (q < qend) {
#pragma unroll
        for (int ps = 0; ps < 8; ++ps)
#pragma unroll
            for (int i = 0; i < 4; ++i) lf[(kr + 32 * ps) * 65 + c4 * 4 + i] = v[ps][i];
        __syncthreads();
        const int qn = q + stride;
        if (qn < qend) { const TrDesc d = tr_desc(p, set, qn);
#pragma unroll
            for (int ps = 0; ps < 8; ++ps) v[ps] = __builtin_nontemporal_load((const f32x4*)(d.src + (size_t)(d.k0 + kr + 32 * ps) * d.ldsrc + d.n0s + c4 * 4)); }
        { const TrDesc d = tr_desc(p, set, q);
#pragma unroll
          for (int qq = 0; qq < 4; ++qq) { float f[8];
#pragma unroll
              for (int jj = 0; jj < 8; ++jj) f[jj] = lf[(kseg * 32 + qq * 8 + jj) * 65 + n];
              *(u32x4*)(d.dst + (size_t)(d.n0d + n) * d.lddst + d.k0 + kseg * 32 + qq * 8) = pack8(f); } }
        __syncthreads();
        q = qn;
    }
}

__device__ __forceinline__ void phase_prep(const Params& p, LAS unsigned char* lds, int bid, int nb) {
    const int tid = threadIdx.x;
    LAS float* lf = (LAS float*)lds;
    float* modp = (float*)(p.ws + OFF_MODP);
    constexpr int NT_ADA = 192, NT_TR = 896 + 256 + 16, NT_SP = 32;
    for (int t = bid; t < NT_ADA; t += nb) {
        {
            const int l = t / 96, jblk = (t % 96) / 8, ks = t % 8;
            for (int e = tid; e < 5 * 256; e += 512) { const int r = e >> 8, kk = e & 255, k = ks * 256 + kk; const float cv = r < 4 ? p.c[r * 2048 + k] : p.cctx[k]; lf[e] = silu_f(cv); }
            __syncthreads();
            const int sub = tid >> 7, ct = tid & 127, j = jblk * 512 + ct * 4;
            float acc[5][4];
#pragma unroll
            for (int r = 0; r < 5; ++r)
#pragma unroll
                for (int i = 0; i < 4; ++i) acc[r][i] = 0.f;
            const float* wp = p.ada_w + ((size_t)l * 2048 + ks * 256 + sub * 64) * 6144 + j;
#pragma unroll 8
            for (int kk = 0; kk < 64; ++kk) { const f32x4 w = __builtin_nontemporal_load((const f32x4*)(wp + (size_t)kk * 6144));
#pragma unroll
                for (int r = 0; r < 5; ++r) { const float s = lf[r * 256 + sub * 64 + kk];
#pragma unroll
                    for (int i = 0; i < 4; ++i) acc[r][i] += s * w[i]; } }
            __syncthreads();
            LAS float* red = lf + 2048;
#pragma unroll
            for (int r = 0; r < 5; ++r)
#pragma unroll
                for (int i = 0; i < 4; ++i) red[(sub * 5 + r) * 512 + ct * 4 + i] = acc[r][i];
            __syncthreads();
            for (int e = tid; e < 2560; e += 512) { const int r = e >> 9, jj = e & 511;
                const float s = red[(0 + r) * 512 + jj] + red[(5 + r) * 512 + jj] + red[(10 + r) * 512 + jj] + red[(15 + r) * 512 + jj];
                modp[((size_t)(ks * 2 + l) * 5 + r) * 6144 + jblk * 512 + jj] = s; }
            __syncthreads();
        }
    }
    { const int rot = (bid + nb - (NT_ADA % nb)) % nb; tr_loop(p, lds, 0, rot, NT_TR, nb); }
    for (int t = bid; t < NT_SP; t += nb) {
        {
            const int s = t; const size_t e0 = (size_t)s * 4096 + tid * 8;
            const f32x4 a = *(const f32x4*)(p.w_sp + e0), b = *(const f32x4*)(p.w_sp + e0 + 4);
            float f[8] = {a[0], a[1], a[2], a[3], b[0], b[1], b[2], b[3]};
            *(u32x4*)((bf16_t*)(p.ws + OFF_WSP) + e0) = pack8(f);
        }
    }
}

__device__ __forceinline__ void phase_mod0(const Params& p, LAS unsigned char* lds, int bid, int nb) {
    const int tid = threadIdx.x, lane = tid & 63, wid = tid >> 6;
    const float* modp = (const float*)(p.ws + OFF_MODP);
    float* mod = (float*)(p.ws + OFF_MOD);
    for (int e = bid * 512 + tid; e < 61440; e += nb * 512) { const int l = e / 30720, rem = e % 30720, r = rem / 6144, j = rem % 6144;
        float s = p.ada_b[l * 6144 + j];
#pragma unroll
        for (int ks = 0; ks < 8; ++ks) s += modp[((size_t)(ks * 2 + l) * 5 + r) * 6144 + j];
        mod[e] = s; }
    const int c0 = tid * 4;
    float wg[4][16];
#pragma unroll
    for (int i = 0; i < 4; ++i)
#pragma unroll
        for (int g4 = 0; g4 < 4; ++g4) { const f32x4 w4 = *(const f32x4*)(p.w_in_even + (size_t)(c0 + i) * 7184 + 5120 + g4 * 4);
#pragma unroll
            for (int q = 0; q < 4; ++q) wg[i][g4 * 4 + q] = w4[q]; }
    LAS float* part = (LAS float*)lds;
    bf16_t* XM = (bf16_t*)(p.ws + OFF_XM); float* GATES = (float*)(p.ws + OFF_GATES);
    for (int t = bid; t < 256; t += nb) {
        const int r0 = t * 36; int curmr = -1; float sh[4] = {0.f, 0.f, 0.f, 0.f}, sc[4] = {0.f, 0.f, 0.f, 0.f};
        f32x4 xn[4], xn2[4];
#pragma unroll
        for (int u = 0; u < 4; ++u) { const int r = r0 + u; const float* src = r < 8192 ? p.x + (size_t)r * 2048 : p.ctx + (size_t)(r - 8192) * 2048; xn[u] = __builtin_nontemporal_load((const f32x4*)(src + c0)); }
#pragma unroll
        for (int u = 0; u < 4; ++u) { const int r = r0 + 4 + u; const float* src = r < 8192 ? p.x + (size_t)r * 2048 : p.ctx + (size_t)(r - 8192) * 2048; xn2[u] = __builtin_nontemporal_load((const f32x4*)(src + c0)); }
        for (int rr = 0; rr < 36; rr += 4) {
            const int rb = r0 + rr; const int mr = rb < 8192 ? (rb >> 11) : 4;
            f32x4 xv[4];
#pragma unroll
            for (int u = 0; u < 4; ++u) { xv[u] = xn[u]; xn[u] = xn2[u]; }
            {
#pragma unroll
                for (int u = 0; u < 4; ++u) { int r = rb + 8 + u; r = r < r0 + 36 ? r : r0 + 35; const float* src = r < 8192 ? p.x + (size_t)r * 2048 : p.ctx + (size_t)(r - 8192) * 2048; xn2[u] = __builtin_nontemporal_load((const f32x4*)(src + c0)); } }
            if (mr != curmr) { curmr = mr;
#pragma unroll
                for (int i = 0; i < 4; ++i) { float a = p.ada_b[c0 + i], b2 = p.ada_b[2048 + c0 + i];
#pragma unroll
                    for (int ks = 0; ks < 8; ++ks) { a += modp[((size_t)(ks * 2) * 5 + mr) * 6144 + c0 + i]; b2 += modp[((size_t)(ks * 2) * 5 + mr) * 6144 + 2048 + c0 + i]; }
                    sh[i] = a; sc[i] = b2; } }
            float pv[4][16];
#pragma unroll
            for (int u = 0; u < 4; ++u) { float xm[4];
#pragma unroll
                for (int i = 0; i < 4; ++i) xm[i] = xv[u][i] * (1.f + sc[i]) + sh[i];
                u32x2 w; w[0] = cvt_pk_bf16(xm[0], xm[1]); w[1] = cvt_pk_bf16(xm[2], xm[3]);
                *(u32x2*)(XM + (size_t)(rb + u) * 2048 + c0) = w;
#pragma unroll
                for (int g = 0; g < 16; ++g) pv[u][g] = xm[0] * wg[0][g] + xm[1] * wg[1][g] + xm[2] * wg[2][g] + xm[3] * wg[3][g]; }
#define RS_STEP(off, n) _Pragma("unroll") for (int u = 0; u < 4; ++u) _Pragma("unroll") for (int i = 0; i < (n) / 2; ++i) { const float a_ = pv[u][i], b_ = pv[u][i + (n) / 2]; const bool up_ = (lane & (off)) != 0; \
                const float send_ = up_ ? a_ : b_, keep_ = up_ ? b_ : a_; pv[u][i] = keep_ + __shfl_xor(send_, (off)); }
            RS_STEP(32, 16) RS_STEP(16, 8) RS_STEP(8, 4) RS_STEP(4, 2)
#undef RS_STEP
            const int gidx = ((lane >> 5) & 1) * 8 + ((lane >> 4) & 1) * 4 + ((lane >> 3) & 1) * 2 + ((lane >> 2) & 1);
#pragma unroll
            for (int u = 0; u < 4; ++u) { float q = pv[u][0]; q += __shfl_xor(q, 2); q += __shfl_xor(q, 1);
                if ((lane & 3) == 0) part[((rr + u) * 8 + wid) * 16 + gidx] = q; }
        }
        __syncthreads();
        for (int e = tid; e < 36 * 16; e += 512) { const int rr = e >> 4, g = e & 15; float s = 0.f;
#pragma unroll
            for (int w = 0; w < 8; ++w) s += part[(rr * 8 + w) * 16 + g];
            GATES[(size_t)(r0 + rr) * 16 + g] = s; }
        __syncthreads();
    }
}

__device__ __forceinline__ void phase_conv(const Params& p, LAS unsigned char* lds, int bid, int nb) {
    const int tid = threadIdx.x, lane = tid & 63, wid = tid >> 6;
    LAS float* scl = (LAS float*)lds;
    LAS float* ksp = (LAS float*)(lds + 1024);
    const bf16_t* PROJ = (const bf16_t*)(p.ws + OFF_PROJ);
    const float* GATES = (const float*)(p.ws + OFF_GATES);
    float* GA = (float*)(p.ws + OFF_GA); float* GP = (float*)(p.ws + OFF_GP); float* GB = (float*)(p.ws + OFF_GB);
    float* BL = (float*)(p.ws + OFF_BL); float* PX = (float*)(p.ws + OFF_PX); float* KSUM = (float*)(p.ws + OFF_KSUM);
    bf16_t* QK = (bf16_t*)(p.ws + OFF_QK); bf16_t* KHT = (bf16_t*)(p.ws + OFF_XM); bf16_t* VT = (bf16_t*)(p.ws + OFF_VT); bf16_t* R = (bf16_t*)(p.ws + OFF_R);
    const int nmine = nb == 256 ? (bid < 64 ? 3 : (bid < 192 ? 5 : 4)) : (576 + 512 - bid + nb - 1) / nb;
    for (int it = 0; it < nmine; ++it) {
        int t;
        if (nb == 256) { const int nconv = bid < 64 ? 3 : 2; t = it < nconv ? bid + 256 * it : 576 + (bid - 64) + 192 * (it - nconv); }
        else t = bid + nb * it;
        if (t < 576) {
            const int gc = t >> 2, h = t & 3, row0 = gc * 64; int pos0, slen;
            if (gc < 128) { pos0 = (gc & 31) * 64; slen = 2048; } else { pos0 = ((gc - 128) & 3) * 64; slen = 256; }
            if (wid < 2) { const int dir = wid, row = row0 + lane;
                const float gi = GATES[(size_t)row * 16 + dir * 4 + h] + p.b_ig[dir * 4 + h];
                const float gf = GATES[(size_t)row * 16 + 8 + dir * 4 + h] + p.b_fg[dir * 4 + h];
                const float lfv = fminf(gf, 0.f) - log1pf(__expf(-fabsf(gf)));
                float bc = lfv;
                if (dir == 0) {
#pragma unroll
                    for (int off = 1; off < 64; off <<= 1) { const float v = __shfl_up(bc, off); if (lane >= off) bc += v; }
                } else {
#pragma unroll
                    for (int off = 1; off < 64; off <<= 1) { const float v = __shfl_down(bc, off); if (lane + off < 64) bc += v; }
                }
                const float a = gi - bc; float pm = a;
                if (dir == 0) {
#pragma unroll
                    for (int off = 1; off < 64; off <<= 1) { const float v = __shfl_up(pm, off); if (lane >= off) pm = fmaxf(pm, v); }
                } else {
#pragma unroll
                    for (int off = 1; off < 64; off <<= 1) { const float v = __shfl_down(pm, off); if (lane + off < 64) pm = fmaxf(pm, v); }
                }
                const float bl = __shfl(bc, dir == 0 ? 63 : 0), px = __shfl(pm, dir == 0 ? 63 : 0);
                const size_t idx = (size_t)(dir * 4 + h) * 9216 + row; GA[idx] = a; GP[idx] = pm; GB[idx] = bc;
                if (lane == 0) { BL[(dir * 4 + h) * 144 + gc] = bl; PX[(dir * 4 + h) * 144 + gc] = px; }
                scl[dir * 64 + lane] = __expf(a - px);
            }
            {
                const int cg = tid & 63, rg = tid >> 6; const bool isk = cg >= 32; const int ch = (isk ? 1024 : 0) + h * 256 + (cg & 31) * 8;
                float w0[8], w1[8], w2[8];
#pragma unroll
                for (int hq = 0; hq < 2; ++hq) { const f32x4 a0 = *(const f32x4*)(p.conv_qk + ch + hq * 4), a1 = *(const f32x4*)(p.conv_qk + 2048 + ch + hq * 4), a2 = *(const f32x4*)(p.conv_qk + 4096 + ch + hq * 4);
#pragma unroll
                    for (int i = 0; i < 4; ++i) { w0[hq * 4 + i] = a0[i]; w1[hq * 4 + i] = a1[i]; w2[hq * 4 + i] = a2[i]; } }
                float prev[8], cur[8], nxt[8];
                const int s0 = rg * 8;
                u32x4 raw[10];
#pragma unroll
                for (int ii = 0; ii < 10; ++ii) { int sr = s0 - 1 + ii; const int pp = pos0 + sr; if (pp < 0) sr += 1; if (pp >= slen) sr -= 1;
                    raw[ii] = *(const u32x4*)(PROJ + (size_t)(row0 + sr) * 7168 + ch); }
                u32x4 vw[8];
#pragma unroll
                for (int ii = 0; ii < 8; ++ii) vw[ii] = *(const u32x4*)(PROJ + (size_t)(row0 + s0 + ii) * 7168 + 2048 + h * 256 + (cg & 31) * 8);
                if (pos0 + s0 - 1 < 0) raw[0] = (u32x4){0u, 0u, 0u, 0u};
                if (pos0 + s0 + 8 >= slen) raw[9] = (u32x4){0u, 0u, 0u, 0u};
                unpack8(raw[0], prev); unpack8(raw[1], cur);
                const float osc = isk ? 0.0625f : 1.f;
                float o[8][8];
#pragma unroll
                for (int ii = 0; ii < 8; ++ii) { const int s = s0 + ii;
                    unpack8(raw[ii + 2], nxt);
#pragma unroll
                    for (int i = 0; i < 8; ++i) { const float cv = w0[i] * prev[i] + w1[i] * cur[i] + w2[i] * nxt[i]; o[ii][i] = silu_f(cv) * osc; }
                    *(u32x4*)(QK + (size_t)(row0 + s) * 2048 + ch) = pack8(o[ii]);
#pragma unroll
                    for (int i = 0; i < 8; ++i) { prev[i] = cur[i]; cur[i] = nxt[i]; }
                }
                __syncthreads();
                if (isk) { const int kl = (cg & 31) * 8;
#pragma unroll
                    for (int dir = 0; dir < 2; ++dir) { float sc[8];
#pragma unroll
                        for (int ii = 0; ii < 8; ++ii) sc[ii] = scl[dir * 64 + s0 + ii];
                        bf16_t* dst = KHT + ((size_t)((dir * 144 + gc) * 4 + h) * 256 + kl) * 64 + s0;
#pragma unroll
                        for (int i = 0; i < 8; ++i) { u32x4 w; float ks = 0.f;
#pragma unroll
                            for (int j = 0; j < 4; ++j) { const float a = o[2 * j][i] * sc[2 * j], b2 = o[2 * j + 1][i] * sc[2 * j + 1]; w[j] = cvt_pk_bf16(a, b2); ks += a + b2; }
                            *(u32x4*)(dst + (size_t)i * 64) = w;
                            ksp[(rg * 2 + dir) * 256 + kl + i] = ks; } }
                } else { bf16_t* dst = VT + ((size_t)(gc * 4 + h) * 256 + cg * 8) * 64 + s0;
#pragma unroll
                    for (int i = 0; i < 8; ++i) { u32x4 w;
#pragma unroll
                        for (int j = 0; j < 4; ++j) { const unsigned a = vw[2 * j][i >> 1], b2 = vw[2 * j + 1][i >> 1]; w[j] = (i & 1) ? ((a >> 16) | (b2 & 0xffff0000u)) : ((a & 0xffffu) | (b2 << 16)); }
                        *(u32x4*)(dst + (size_t)i * 64) = w; } }
            }
            __syncthreads();
            { const int dir = tid >> 8, k = tid & 255; float sum = 0.f;
#pragma unroll
              for (int rg = 0; rg < 8; ++rg) sum += ksp[(rg * 2 + dir) * 256 + k];
              KSUM[(size_t)((dir * 144 + gc) * 4 + h) * 256 + k] = sum; }
            __syncthreads();
        } else {
            const int tr = t - 576, seg = tr >> 2, g = tr & 3; const int row0 = seg * 64;
            LAS bf16_t* ut = (LAS bf16_t*)lds;
#pragma unroll
            for (int i = 0; i < 4; ++i) { const int e = tid + 512 * i, r = e >> 5, c = e & 31;
                *(LAS u32x4*)(ut + r * 264 + c * 8) = *(const u32x4*)(PROJ + (size_t)(row0 + r) * 7168 + 5120 + g * 256 + c * 8); }
            __syncthreads();
            { const int c8 = tid & 31, w = 2 << g; const float invw = 1.f / (float)w;
#pragma unroll
              for (int k = 0; k < 4; ++k) { const int pos = (tid >> 5) + 16 * k; const int lo = max(pos - w / 2, 0), hi = min(pos + (w - 1 - w / 2), 63);
                  float sum[8];
#pragma unroll
                  for (int q = 0; q < 8; ++q) sum[q] = 0.f;
                  for (int rr = lo; rr <= hi; ++rr) { float f[8]; unpack8(*(const LAS u32x4*)(ut + rr * 264 + c8 * 8), f);
#pragma unroll
                      for (int q = 0; q < 8; ++q) sum[q] += f[q]; }
                  float u[8]; unpack8(*(const LAS u32x4*)(ut + pos * 264 + c8 * 8), u);
                  const float inv = (hi - lo + 1 == w) ? invw : 1.f / (float)(hi - lo + 1); float o[8];
#pragma unroll
                  for (int q = 0; q < 8; ++q) o[q] = sum[q] * inv - u[q];
                  *(u32x4*)(R + (size_t)(row0 + pos) * 1024 + g * 256 + c8 * 8) = pack8(o); } }
            __syncthreads();
        }
    }
}

__device__ __forceinline__ void phase_intra(const Params& p, LAS unsigned char* lds, int bid, int nb) {
    const int tid = threadIdx.x, lane = tid & 63, wid = tid >> 6, quad = lane >> 4, l15 = lane & 15;
    LAS bf16_t* Qs = (LAS bf16_t*)lds;
    LAS bf16_t* Ks = (LAS bf16_t*)(lds + 33792);
    LAS bf16_t* Vs = (LAS bf16_t*)(lds + 67584);
    LAS bf16_t* Ps = (LAS bf16_t*)(lds + 104448);
    LAS float* fs = (LAS float*)(lds + 113664);
    LAS float* a_s = fs; LAS float* pm_s = fs + 64; LAS float* bc_s = fs + 128; LAS float* nvec = fs + 192; LAS float* rsp = fs + 448; LAS float* coef_s = fs + 576; LAS float* qn_s = fs + 640; LAS float* bl_s = fs + 704; LAS float* px_s = fs + 768;
    const float* GA = (const float*)(p.ws + OFF_GA); const float* GP = (const float*)(p.ws + OFF_GP); const float* GB = (const float*)(p.ws + OFF_GB);
    const float* BL = (const float*)(p.ws + OFF_BL); const float* PX = (const float*)(p.ws + OFF_PX); const float* KSUM = (const float*)(p.ws + OFF_KSUM);
    float* GAM = (float*)(p.ws + OFF_GAM);
    const bf16_t* QK = (const bf16_t*)(p.ws + OFF_QK); const bf16_t* VT = (const bf16_t*)(p.ws + OFF_VT);
    for (int t = bid; t < 1024; t += nb) {
        const int dir = t >> 9, b = (t >> 7) & 3, h = (t >> 5) & 3, lc = t & 31;
        const int gc = b * 32 + lc, row0 = gc * 64, dh = dir * 4 + h;
        bf16_t* Hd = (bf16_t*)(p.ws + OFF_H) + (size_t)(dir * 2) * 8192 * 1024;
        float m = 0.f, nk = 0.f; const int k = tid & 255;
        const int nprev = dir == 0 ? 4 + lc : 4 + (31 - lc);
#define INTRA_G2(i_) ((i_) < 4 ? 128 + b * 4 + (dir == 0 ? (i_) : 3 - (i_)) : b * 32 + (dir == 0 ? (i_) - 4 : 35 - (i_)))
        if (tid < nprev) { const int g2 = INTRA_G2(tid); bl_s[tid] = BL[dh * 144 + g2]; px_s[tid] = PX[dh * 144 + g2]; }
        __syncthreads();
        { int i = 0;
          for (; i + 4 <= nprev; i += 4) { float ks[4];
#pragma unroll
              for (int u = 0; u < 4; ++u) { const int g2 = INTRA_G2(i + u); ks[u] = KSUM[(size_t)((dir * 144 + g2) * 4 + h) * 256 + k]; }
#pragma unroll
              for (int u = 0; u < 4; ++u) { const float px = px_s[i + u], mm = fmaxf(px, m); const float dec = __expf(m - mm), sig = __expf(px - mm); nk = dec * nk + sig * ks[u]; m = bl_s[i + u] + mm; } }
          for (; i < nprev; ++i) { const int g2 = INTRA_G2(i); const float ksv = KSUM[(size_t)((dir * 144 + g2) * 4 + h) * 256 + k];
              const float px = px_s[i], mm = fmaxf(px, m); const float dec = __expf(m - mm), sig = __expf(px - mm); nk = dec * nk + sig * ksv; m = bl_s[i] + mm; } }
#undef INTRA_G2
        if (tid < 256) nvec[tid] = nk;
        if (tid < 64) { a_s[tid] = GA[(size_t)dh * 9216 + row0 + tid]; pm_s[tid] = GP[(size_t)dh * 9216 + row0 + tid]; bc_s[tid] = GB[(size_t)dh * 9216 + row0 + tid]; }
#pragma unroll
        for (int i = 0; i < 4; ++i) { const int e = tid + 512 * i, r = e >> 5, c = e & 31;
            *(LAS u32x4*)(Qs + r * 264 + c * 8) = *(const u32x4*)(QK + (size_t)(row0 + r) * 2048 + h * 256 + c * 8);
            *(LAS u32x4*)(Ks + r * 264 + c * 8) = *(const u32x4*)(QK + (size_t)(row0 + r) * 2048 + 1024 + h * 256 + c * 8); }
#pragma unroll
        for (int i = 0; i < 4; ++i) { const int e = tid + 512 * i, r = e >> 3, c = e & 7;
            *(LAS u32x4*)(Vs + r * 72 + c * 8) = *(const u32x4*)(VT + ((size_t)(gc * 4 + h) * 256 + r) * 64 + c * 8); }
        __syncthreads();
        {
            const int tt = wid & 3, sp = wid >> 2; float rsum = 0.f; const int tcol = tt * 16 + l15; const float pmt = pm_s[tcol];
#pragma unroll
            for (int q = 0; q < 2; ++q) { const int st = sp * 2 + q; f32x4 acc = {0.f, 0.f, 0.f, 0.f};
#pragma unroll
                for (int ks = 0; ks < 8; ++ks) { const bf16x8 a = ldfrag(Ks, 264, st * 16 + l15, ks * 32 + quad * 8); const bf16x8 bq = ldfrag(Qs, 264, tt * 16 + l15, ks * 32 + quad * 8); acc = MFMA16(a, bq, acc); }
                float pv[4];
#pragma unroll
                for (int j = 0; j < 4; ++j) { const int s = st * 16 + quad * 4 + j; const bool valid = dir == 0 ? (s <= tcol) : (s >= tcol);
                    const float e = __expf(fminf(a_s[s] - pmt, 0.f)); pv[j] = valid ? acc[j] * e : 0.f; rsum += pv[j]; }
                u32x2 w; w[0] = cvt_pk_bf16(pv[0], pv[1]); w[1] = cvt_pk_bf16(pv[2], pv[3]);
                *(LAS u32x2*)(Ps + tcol * 72 + st * 16 + quad * 4) = w; }
            rsum += __shfl_xor(rsum, 16); rsum += __shfl_xor(rsum, 32);
            if (quad == 0) rsp[sp * 64 + tcol] = rsum;
        }
        {
            const int t2 = tid >> 3, j8 = tid & 7; float qn = 0.f;
#pragma unroll
            for (int kk = 0; kk < 32; kk += 8) { float f[8]; unpack8(*(const LAS u32x4*)(Qs + t2 * 264 + j8 * 32 + kk), f);
#pragma unroll
                for (int i = 0; i < 8; ++i) qn += f[i] * nvec[j8 * 32 + kk + i]; }
            qn += __shfl_xor(qn, 1); qn += __shfl_xor(qn, 2); qn += __shfl_xor(qn, 4);
            if (j8 == 0) qn_s[t2] = qn;
        }
        __syncthreads();
        if (tid < 64) { const float mm = fmaxf(pm_s[tid], m); const float rho = __expf(pm_s[tid] - mm), wi = __expf(m - mm), thr = __expf(-bc_s[tid] - mm);
            const float den = rho * (rsp[tid] + rsp[64 + tid]) + wi * qn_s[tid]; const float Dn = fmaxf(fabsf(den), thr);
            coef_s[tid] = rho / Dn; GAM[(size_t)dh * 8192 + row0 + tid] = wi / Dn; }
        __syncthreads();
        {
#pragma unroll
            for (int v2 = 0; v2 < 2; ++v2) { const int vt_ = wid * 2 + v2;
                const bf16x8 a0 = ldfrag(Vs, 72, vt_ * 16 + l15, quad * 8), a1 = ldfrag(Vs, 72, vt_ * 16 + l15, 32 + quad * 8);
#pragma unroll
                for (int tt = 0; tt < 4; ++tt) { f32x4 acc = {0.f, 0.f, 0.f, 0.f};
                    acc = MFMA16(a0, ldfrag(Ps, 72, tt * 16 + l15, quad * 8), acc); acc = MFMA16(a1, ldfrag(Ps, 72, tt * 16 + l15, 32 + quad * 8), acc);
                    const int tq = tt * 16 + l15; const float cf = coef_s[tq];
                    { const f32x4 o = acc * cf; u32x2 w; w[0] = cvt_pk_bf16(o[0], o[1]); w[1] = cvt_pk_bf16(o[2], o[3]);
                      *(u32x2*)(Hd + (size_t)(row0 + tq) * 1024 + h * 256 + vt_ * 16 + quad * 4) = w; } } }
        }
        __syncthreads();
    }
}

struct ScanS { u32x4 q[4]; u32x4 v; float g; };
struct ScanD { bf16x8 ka[2][2]; };
__device__ __forceinline__ void phase_scan(const Params& p, LAS unsigned char* lds, int bid, int nb, bool dry) {
    if (bid >= 256) return;
    const int tid = threadIdx.x, lane = tid & 63, wid = tid >> 6, quad = lane >> 4, l15 = lane & 15;
    int slot;
    { volatile LAS unsigned* bst = (volatile LAS unsigned*)(lds + 131072); const unsigned xcc = bst[2], r = bst[3]; unsigned ov = bst[4];
      if (gridDim.x != 256) slot = bid;
      else if (ov == 0u) slot = (int)(xcc * 32u + r);
      else { unsigned* bw = (unsigned*)(p.ws + OFF_BAR); ov -= 1u; slot = 0;
             for (unsigned x = 0; x < 8u; ++x) { unsigned c = __hip_atomic_load(&bw[3600 + x], __ATOMIC_RELAXED, __HIP_MEMORY_SCOPE_AGENT); c = c < 32u ? c : 32u; const unsigned fr = 32u - c; if (ov < fr) { slot = (int)(x * 32u + c + ov); break; } ov -= fr; } } }
    const int seq = slot >> 3, vs = slot & 7, dir = seq >> 4, b = (seq >> 2) & 3, h = seq & 3, dh = dir * 4 + h;
    constexpr int SET = 55552;
    LAS float* decs = (LAS float*)(lds + 2 * SET);
    LAS float* sigs = decs + 64; LAS float* pxs = decs + 128; LAS float* bls = decs + 192;
    const float* BL = (const float*)(p.ws + OFF_BL); const float* PX = (const float*)(p.ws + OFF_PX); const float* GAM = (const float*)(p.ws + OFF_GAM);
    const bf16_t* QK = (const bf16_t*)(p.ws + OFF_QK); const bf16_t* VT = (const bf16_t*)(p.ws + OFF_VT); const bf16_t* KHT = (const bf16_t*)(p.ws + OFF_XM);
    bf16_t* Hd = (bf16_t*)(p.ws + OFF_H) + (size_t)(dir * 2 + 1) * 8192 * 1024;
    const int tt = wid & 3, vt_ = wid >> 2, tq = tt * 16 + l15;
#define SCAN_GC(i_) const int jj = dir == 0 ? (i_) : ((i_) < 4 ? 3 - (i_) : 39 - (i_)); const bool lat = jj >= 4; const int gc = lat ? b * 32 + (jj - 4) : 128 + b * 4 + jj; const int row0 = gc * 64;
    if (tid < 36) { SCAN_GC(tid) (void)row0; pxs[tid] = PX[dh * 144 + gc]; bls[tid] = BL[dh * 144 + gc]; }
    __syncthreads();
    if (tid == 0) { float m = 0.f; for (int i = 0; i < 36; ++i) { const float px = pxs[i], mm = fmaxf(px, m); decs[i] = __expf(m - mm); sigs[i] = __expf(px - mm); m = bls[i] + mm; } }
    auto issueS = [&](ScanS& S, int i0) {
        const int i = i0 < 36 ? i0 : 35;
        SCAN_GC(i)
        const int rowc = lat ? row0 : b * 2048;
        S.v = *(const u32x4*)(VT + ((size_t)(gc * 4 + h) * 256 + vs * 32) * 64 + (tid & 255) * 8);
#pragma unroll
        for (int q = 0; q < 4; ++q) { const int e = tid + 512 * q, r = e >> 5, c = e & 31; S.q[q] = *(const u32x4*)(QK + (size_t)(rowc + r) * 2048 + h * 256 + c * 8); }
        S.g = 0.f;
    };
    auto stageS = [&](ScanS& S, int i) {
        LAS unsigned char* sb = lds + (i & 1) * SET;
        *(LAS u32x4*)((LAS bf16_t*)(sb + 33792) + ((tid & 255) >> 3) * 72 + (tid & 7) * 8) = S.v;
#pragma unroll
        for (int q = 0; q < 4; ++q) { const int e = tid + 512 * q; *(LAS u32x4*)((LAS bf16_t*)sb + (e >> 5) * 264 + (e & 31) * 8) = S.q[q]; }
    };
    auto issueD = [&](ScanD& D, int i0) {
        const int i = i0 < 36 ? i0 : 35;
        SCAN_GC(i)
        const int rowc = lat ? row0 : b * 2048;
        const bf16_t* ksrc = KHT + (size_t)((dir * 144 + gc) * 4 + h) * 256 * 64;
#pragma unroll
        for (int k2 = 0; k2 < 2; ++k2) { const bf16_t* rp = ksrc + (size_t)((wid * 2 + k2) * 16 + l15) * 64 + quad * 8; D.ka[k2][0] = *(const bf16x8*)rp; D.ka[k2][1] = *(const bf16x8*)(rp + 32); }
        (void)rowc;
    };
    f32x4 C[2][2];
#pragma unroll
    for (int a = 0; a < 2; ++a)
#pragma unroll
        for (int c = 0; c < 2; ++c) C[a][c] = (f32x4){0.f, 0.f, 0.f, 0.f};
    auto step = [&](ScanD& D, ScanS& So, int i) {
        SCAN_GC(i)
        const int rowc = lat ? row0 : b * 2048;
        const LAS unsigned char* rb = lds + (i & 1) * SET; LAS unsigned char* wb = lds + ((i + 1) & 1) * SET;
        const LAS bf16_t* Qs = (const LAS bf16_t*)rb; const LAS bf16_t* Vs = (const LAS bf16_t*)(rb + 33792); const LAS bf16_t* Cr = (const LAS bf16_t*)(rb + 38400);
        LAS bf16_t* Cw = (LAS bf16_t*)(wb + 38400);
        stageS(So, i + 1);
        issueS(So, i + 3);
        const float dec = decs[i], sig = sigs[i];
        const bf16x8 vb00 = ldfrag(Vs, 72, l15, quad * 8), vb01 = ldfrag(Vs, 72, l15, 32 + quad * 8), vb10 = ldfrag(Vs, 72, 16 + l15, quad * 8), vb11 = ldfrag(Vs, 72, 16 + l15, 32 + quad * 8);
        { f32x4 acc = {0.f, 0.f, 0.f, 0.f};
            bf16x8 ca[8], qb[8];
#pragma unroll
            for (int ks = 0; ks < 8; ++ks) { ca[ks] = ldfrag(Cr, 264, vt_ * 16 + l15, ks * 32 + quad * 8); qb[ks] = ldfrag(Qs, 264, tt * 16 + l15, ks * 32 + quad * 8); }
            const float g = !lat ? 0.f : 1.f;
#pragma unroll
            for (int ks = 0; ks < 8; ++ks) acc = MFMA16(ca[ks], qb[ks], acc);
            { const f32x4 o = acc * g; u32x2 w; w[0] = cvt_pk_bf16(o[0], o[1]); w[1] = cvt_pk_bf16(o[2], o[3]);
              *(u32x2*)(Hd + (size_t)(rowc + tq) * 1024 + h * 256 + vs * 32 + vt_ * 16 + quad * 4) = w; } }
#pragma unroll
        for (int v2 = 0; v2 < 2; ++v2) { const bf16x8 b0 = v2 ? vb10 : vb00, b1 = v2 ? vb11 : vb01;
#pragma unroll
            for (int k2 = 0; k2 < 2; ++k2) { f32x4 d = {0.f, 0.f, 0.f, 0.f};
                d = MFMA16(D.ka[k2][0], b0, d); d = MFMA16(D.ka[k2][1], b1, d);
                C[k2][v2] = C[k2][v2] * dec + d * sig;
                u32x2 w; w[0] = cvt_pk_bf16(C[k2][v2][0], C[k2][v2][1]); w[1] = cvt_pk_bf16(C[k2][v2][2], C[k2][v2][3]);
                *(LAS u32x2*)(Cw + (v2 * 16 + l15) * 264 + (wid * 2 + k2) * 16 + quad * 4) = w; } }
        issueD(D, i + 2);
        asm volatile("s_waitcnt lgkmcnt(0)\n\ts_barrier" ::: "memory");
    };
    for (int e = tid; e < 2 * SET / 16; e += 512) *(LAS u32x4*)(lds + e * 16) = (u32x4){0u, 0u, 0u, 0u};
    __syncthreads();
    ScanS Sa, Sb; ScanD D0, D1;
    issueS(Sa, 0); issueD(D0, 0); issueD(D1, 1); issueS(Sb, 1);
    stageS(Sa, 0); issueS(Sa, 2);
    __syncthreads();
    for (int i = 0; i < 36; i += 2) { step(D0, Sb, i); step(D1, Sa, i + 1); }
#undef SCAN_GC
}

__device__ __forceinline__ void phase_mout(const Params& p, int it_lo, int it_hi, int wave0, int nwaves) {
    const int lane = threadIdx.x & 63;
    const bf16_t* H4 = (const bf16_t*)(p.ws + OFF_H); constexpr size_t HPL = (size_t)8192 * 1024;
    const float* GAM = (const float*)(p.ws + OFF_GAM);
    const bf16_t* PROJ = (const bf16_t*)(p.ws + OFF_PROJ); bf16_t* Y = (bf16_t*)(p.ws + OFF_QK);
    for (int it0 = it_lo + wave0; it0 < it_hi; it0 += 4 * nwaves) {
        f32x4 hf[4], hb[4]; u32x2 ow[4], zw[4]; f32x4 gg[4]; float hv[4][4], s[4], v[4];
#pragma unroll
        for (int u = 0; u < 4; ++u) { int it = it0 + u * nwaves; if (it >= it_hi) it = it0; const int row = it >> 2, h = it & 3, c = h * 256 + lane * 4;
            { const u32x2 a0 = *(const u32x2*)(H4 + (size_t)row * 1024 + c), a1 = *(const u32x2*)(H4 + HPL + (size_t)row * 1024 + c), a2 = *(const u32x2*)(H4 + 2 * HPL + (size_t)row * 1024 + c), a3 = *(const u32x2*)(H4 + 3 * HPL + (size_t)row * 1024 + c);
              const float gf = GAM[(size_t)h * 8192 + row], gb = GAM[(size_t)(4 + h) * 8192 + row];
              hf[u] = (f32x4){bflo(a0[0]) + gf * bflo(a1[0]), bfhi(a0[0]) + gf * bfhi(a1[0]), bflo(a0[1]) + gf * bflo(a1[1]), bfhi(a0[1]) + gf * bfhi(a1[1])};
              hb[u] = (f32x4){bflo(a2[0]) + gb * bflo(a3[0]), bfhi(a2[0]) + gb * bfhi(a3[0]), bflo(a2[1]) + gb * bflo(a3[1]), bfhi(a2[1]) + gb * bfhi(a3[1])}; }
            ow[u] = *(const u32x2*)(PROJ + (size_t)row * 7168 + 3072 + c); zw[u] = *(const u32x2*)(PROJ + (size_t)row * 7168 + 4096 + c);
            gg[u] = *(const f32x4*)(p.mh_g + c); }
#pragma unroll
        for (int u = 0; u < 4; ++u) { const float o[4] = {bflo(ow[u][0]), bfhi(ow[u][0]), bflo(ow[u][1]), bfhi(ow[u][1])}; s[u] = 0.f;
#pragma unroll
            for (int i = 0; i < 4; ++i) { hv[u][i] = (hf[u][i] + hb[u][i]) * sigm_f(o[i]); s[u] += hv[u][i]; } }
#pragma unroll
        for (int u = 0; u < 4; ++u) s[u] = wave_sum(s[u]);
#pragma unroll
        for (int u = 0; u < 4; ++u) { const float mu = s[u] * (1.f / 256.f); v[u] = 0.f;
#pragma unroll
            for (int i = 0; i < 4; ++i) { hv[u][i] -= mu; v[u] += hv[u][i] * hv[u][i]; } }
#pragma unroll
        for (int u = 0; u < 4; ++u) v[u] = wave_sum(v[u]);
#pragma unroll
        for (int u = 0; u < 4; ++u) { const int it = it0 + u * nwaves; if (it < it_hi) { const int row = it >> 2, h = it & 3, c = h * 256 + lane * 4;
            const float rstd = rsqrtf(v[u] * (1.f / 256.f) + 1e-5f);
            const float z[4] = {bflo(zw[u][0]), bfhi(zw[u][0]), bflo(zw[u][1]), bfhi(zw[u][1])}; float y[4];
#pragma unroll
            for (int i = 0; i < 4; ++i) y[i] = hv[u][i] * rstd * gg[u][i] * silu_f(z[i]);
            u32x2 w; w[0] = cvt_pk_bf16(y[0], y[1]); w[1] = cvt_pk_bf16(y[2], y[3]);
            *(u32x2*)(Y + (size_t)row * 2048 + c) = w; } }
    }
}

__device__ __forceinline__ void phase_ln(const Params& p, int layer, bool domod, int wave0, int nwaves) {
    const int lane = threadIdx.x & 63;
    const float* mod1 = (const float*)(p.ws + OFF_MOD) + 5 * 6144;
    bf16_t* XM1 = (bf16_t*)(p.ws + OFF_XM);
    for (int row = wave0; row < 8192; row += nwaves) { float* rp = p.out + (size_t)row * 2048; const int b = row >> 11;
        f32x4 v[8]; float s = 0.f;
#pragma unroll
        for (int i = 0; i < 8; ++i) { v[i] = *(const f32x4*)(rp + (i * 64 + lane) * 4); s += v[i][0] + v[i][1] + v[i][2] + v[i][3]; }
#pragma unroll
        for (int off = 1; off < 64; off <<= 1) s += __shfl_xor(s, off);
        const float mu = s * (1.f / 2048.f); float q = 0.f;
#pragma unroll
        for (int i = 0; i < 8; ++i) { v[i] -= mu; q += v[i][0] * v[i][0] + v[i][1] * v[i][1] + v[i][2] * v[i][2] + v[i][3] * v[i][3]; }
#pragma unroll
        for (int off = 1; off < 64; off <<= 1) q += __shfl_xor(q, off);
        const float rstd = rsqrtf(q * (1.f / 2048.f) + 1e-5f);
#pragma unroll
        for (int i = 0; i < 8; ++i) { const int col = (i * 64 + lane) * 4;
            const f32x4 g = *(const f32x4*)(p.pln_g + layer * 2048 + col), bb = *(const f32x4*)(p.pln_b + layer * 2048 + col);
            const f32x4 y = v[i] * rstd * g + bb; *(f32x4*)(rp + col) = y;
            if (domod) { const f32x4 sh = *(const f32x4*)(mod1 + (size_t)b * 6144 + col), sc = *(const f32x4*)(mod1 + (size_t)b * 6144 + 2048 + col);
                const f32x4 xm = y * (sc + 1.f) + sh; u32x2 w; w[0] = cvt_pk_bf16(xm[0], xm[1]); w[1] = cvt_pk_bf16(xm[2], xm[3]);
                *(u32x2*)(XM1 + (size_t)row * 2048 + col) = w; } }
    }
}

__device__ __forceinline__ void phase_sguln(const Params& p, LAS unsigned char* lds, int bid, int nb) {
    const int tid = threadIdx.x, lane = tid & 63, wid = tid >> 6;
    LAS bf16_t* tile = (LAS bf16_t*)lds;
    const bf16_t* PROJ1 = (const bf16_t*)(p.ws + OFF_PROJ); bf16_t* VNT = (bf16_t*)(p.ws + OFF_H);
    for (int t = bid; t < 256; t += nb) { const int b = t >> 6, n = (t >> 2) & 15, rq = t & 3; const int row0 = b * 2048 + n * 128 + rq * 32;
        u32x4 raw[4][4];
#pragma unroll
        for (int rr = 0; rr < 4; ++rr)
#pragma unroll
            for (int i = 0; i < 4; ++i) raw[rr][i] = *(const u32x4*)(PROJ1 + (size_t)(row0 + wid * 4 + rr) * 6144 + 2048 + (i * 64 + lane) * 8);
        float mu[4], rs[4];
        { float s[4];
#pragma unroll
          for (int rr = 0; rr < 4; ++rr) { s[rr] = 0.f;
#pragma unroll
              for (int i = 0; i < 4; ++i) { float f[8]; unpack8(raw[rr][i], f);
#pragma unroll
                  for (int q = 0; q < 8; ++q) s[rr] += f[q]; } }
#pragma unroll
          for (int off = 1; off < 64; off <<= 1) {
#pragma unroll
              for (int rr = 0; rr < 4; ++rr) s[rr] += __shfl_xor(s[rr], off); }
          float v[4];
#pragma unroll
          for (int rr = 0; rr < 4; ++rr)
#pragma unroll
              for (int i = 0; i < 4; ++i) asm volatile("" : "+v"(raw[rr][i]));
#pragma unroll
          for (int rr = 0; rr < 4; ++rr) { mu[rr] = s[rr] * (1.f / 2048.f); v[rr] = 0.f;
#pragma unroll
              for (int i = 0; i < 4; ++i) { float f[8]; unpack8(raw[rr][i], f);
#pragma unroll
                  for (int q = 0; q < 8; ++q) { const float d = f[q] - mu[rr]; v[rr] += d * d; } } }
#pragma unroll
          for (int off = 1; off < 64; off <<= 1) {
#pragma unroll
              for (int rr = 0; rr < 4; ++rr) v[rr] += __shfl_xor(v[rr], off); }
#pragma unroll
          for (int rr = 0; rr < 4; ++rr) rs[rr] = rsqrtf(v[rr] * (1.f / 2048.f) + 1e-5f); }
#pragma unroll
        for (int rr = 0; rr < 4; ++rr)
#pragma unroll
            for (int i = 0; i < 4; ++i) asm volatile("" : "+v"(raw[rr][i]));
#pragma unroll
        for (int half = 0; half < 2; ++half) {
#pragma unroll
            for (int ii = 0; ii < 2; ++ii) { const int i = half * 2 + ii; const int col = (i * 64 + lane) * 8;
                const f32x4 g0 = *(const f32x4*)(p.sgu_g + col), g1 = *(const f32x4*)(p.sgu_g + col + 4), b0 = *(const f32x4*)(p.sgu_b + col), b1 = *(const f32x4*)(p.sgu_b + col + 4);
                float f[4][8];
#pragma unroll
                for (int rr = 0; rr < 4; ++rr) unpack8(raw[rr][i], f[rr]);
#pragma unroll
                for (int q = 0; q < 8; ++q) { const float gq = q < 4 ? g0[q & 3] : g1[q & 3], bq = q < 4 ? b0[q & 3] : b1[q & 3];
                    float y[4];
#pragma unroll
                    for (int rr = 0; rr < 4; ++rr) y[rr] = (f[rr][q] - mu[rr]) * rs[rr] * gq + bq;
                    u32x2 w; w[0] = cvt_pk_bf16(y[0], y[1]); w[1] = cvt_pk_bf16(y[2], y[3]);
                    *(LAS u32x2*)(tile + (q * 128 + ii * 64 + lane) * 36 + wid * 4) = w; } }
            __syncthreads();
#pragma unroll
            for (int k = 0; k < 2; ++k) { const int prow = tid + 512 * k; const int c = ((prow & 127) << 3) | (prow >> 7);
                bf16_t* dst = VNT + ((size_t)((b * 16 + n) * 2048 + half * 1024 + c)) * 128 + rq * 32;
#pragma unroll
                for (int q = 0; q < 4; ++q) { const u32x2 lo = *(const LAS u32x2*)(tile + prow * 36 + q * 8), hi = *(const LAS u32x2*)(tile + prow * 36 + q * 8 + 4);
                    u32x4 w; w[0] = lo[0]; w[1] = lo[1]; w[2] = hi[0]; w[3] = hi[1]; *(u32x4*)(dst + q * 8) = w; } }
            __syncthreads();
        }
    }
}

__device__ __forceinline__ void phase_sgu(const Params& p, LAS unsigned char* lds, int bid, int nb) {
    const int tid = threadIdx.x, lane = tid & 63, wid = tid >> 6, quad = lane >> 4, l15 = lane & 15;
    LAS bf16_t* Xs = (LAS bf16_t*)lds;
    LAS bf16_t* Ws = (LAS bf16_t*)(lds + 78336);
    LAS float* st = (LAS float*)(lds + 113152);
    const bf16_t* PROJ1 = (const bf16_t*)(p.ws + OFF_PROJ); const bf16_t* WSP = (const bf16_t*)(p.ws + OFF_WSP); const float* RS2 = (const float*)(p.ws + OFF_RS2);
    bf16_t* Y1 = (bf16_t*)(p.ws + OFF_QK);
    int hloaded = -1;
    const int xrow0 = (l15 & 3) * 36 + 4 * wid + (l15 >> 2);
    for (int t = bid; t < 512; t += nb) { const int h = t & 7, n = (t >> 3) & 15, b = t >> 7; const size_t crow = (size_t)b * 2048 + n * 128;
        if (tid < 128) { const float* src = RS2 + (crow + tid) * 64; float sm = 0.f, sq = 0.f;
#pragma unroll
            for (int j = 0; j < 16; ++j) { const f32x4 v4 = *(const f32x4*)(src + 4 * j); sm += v4[0] + v4[2]; sq += v4[1] + v4[3]; }
            const float mu = sm * (1.f / 2048.f); const float var = fmaxf(sq * (1.f / 2048.f) - mu * mu, 0.f);
            st[tid * 2] = mu; st[tid * 2 + 1] = rsqrtf(var + 1e-5f); }
        if (h != hloaded) { hloaded = h;
#pragma unroll 1
            for (int i = 0; i < 4; ++i) { const int e = tid + 512 * i, r = e >> 4, c = e & 15; *(LAS u32x4*)(Ws + r * 136 + c * 8) = *(const u32x4*)(WSP + (size_t)h * 16384 + r * 128 + c * 8); } }
        const int c8 = tid & 31;
        u32x4 va[4], vb[4];
#pragma unroll
        for (int i = 0; i < 4; ++i) { const int sp = (tid >> 5) + 16 * i; const bf16_t* vp = PROJ1 + (size_t)8192 * 2048 + (crow + 2 * sp) * 2048 + h * 256 + c8 * 8; va[i] = *(const u32x4*)vp; vb[i] = *(const u32x4*)(vp + 2048); }
        float gg[8], bb[8];
        { const f32x4 g0 = *(const f32x4*)(p.sgu_g + h * 256 + c8 * 8), g1 = *(const f32x4*)(p.sgu_g + h * 256 + c8 * 8 + 4), b0 = *(const f32x4*)(p.sgu_b + h * 256 + c8 * 8), b1 = *(const f32x4*)(p.sgu_b + h * 256 + c8 * 8 + 4);
#pragma unroll
          for (int q = 0; q < 4; ++q) { gg[q] = g0[q]; gg[4 + q] = g1[q]; bb[q] = b0[q]; bb[4 + q] = b1[q]; } }
        __syncthreads();
#pragma unroll
        for (int i = 0; i < 4; ++i) { const int sp = (tid >> 5) + 16 * i; float fa[8], fb[8]; unpack8(va[i], fa); unpack8(vb[i], fb);
            const float mua = st[4 * sp], rsa = st[4 * sp + 1], mub = st[4 * sp + 2], rsb = st[4 * sp + 3];
#pragma unroll
            for (int q = 0; q < 8; ++q) { const float ya = (fa[q] - mua) * rsa * gg[q] + bb[q], yb = (fb[q] - mub) * rsb * gg[q] + bb[q];
                *(LAS unsigned*)(Xs + (q * 36 + c8) * 136 + 2 * sp) = cvt_pk_bf16(ya, yb); } }
        __syncthreads();
#pragma unroll 1
        for (int th = 0; th < 2; ++th) {
            f32x4 acc[2][4];
#pragma unroll
            for (int a = 0; a < 2; ++a)
#pragma unroll
                for (int c = 0; c < 4; ++c) acc[a][c] = (f32x4){0.f, 0.f, 0.f, 0.f};
#pragma unroll
            for (int ks = 0; ks < 4; ++ks) { const bf16x8 a0 = ldfrag(Xs, 136, xrow0, ks * 32 + quad * 8), a1 = ldfrag(Xs, 136, xrow0 + 4 * 36, ks * 32 + quad * 8);
#pragma unroll
                for (int tt = 0; tt < 4; ++tt) { const bf16x8 bw = ldfrag(Ws, 136, (th * 4 + tt) * 16 + l15, ks * 32 + quad * 8); acc[0][tt] = MFMA16(a0, bw, acc[0][tt]); acc[1][tt] = MFMA16(a1, bw, acc[1][tt]); } }
#pragma unroll
            for (int tt = 0; tt < 4; ++tt) { const int tq = (th * 4 + tt) * 16 + l15; const size_t row = crow + tq; const int c0 = h * 256 + wid * 32 + quad * 8;
                const float bias = p.b_sp[h * 128 + tq];
                float gz[8], y[8]; unpack8(*(const u32x4*)(PROJ1 + row * 2048 + c0), gz);
#pragma unroll
                for (int q = 0; q < 4; ++q) { y[q] = gz[q] * (acc[0][tt][q] + bias); y[4 + q] = gz[4 + q] * (acc[1][tt][q] + bias); }
                *(u32x4*)(Y1 + row * 2048 + c0) = pack8(y); }
        }
        __syncthreads();
    }
}

#ifndef PHASE_MASK
#define PHASE_MASK 0xFFFF
#endif
#define PH_ON(n) (((PHASE_MASK) >> (n)) & 1)
typedef const __attribute__((address_space(4))) Params* cparams_t;
__device__ __forceinline__ Params ld_params() {
#if defined(__HIP_DEVICE_COMPILE__)
    cparams_t kp = (cparams_t)__builtin_amdgcn_kernarg_segment_ptr();
    asm volatile("" : "+s"(kp));
    Params r;
    typedef const __attribute__((address_space(1))) float* gptr_t;
    const __attribute__((address_space(4))) gptr_t* sp = (const __attribute__((address_space(4))) gptr_t*)kp;
    const float** fp = (const float**)&r;
#pragma unroll
    for (int i = 0; i < (int)(sizeof(Params) / 8); ++i) fp[i] = (const float*)sp[i];
    return r;
#else
    return Params{};
#endif
}
__global__ void __launch_bounds__(512, 2) fwd_megakernel(Params p_first_arg, int ph_lo, int ph_hi, int coop) {
    extern __shared__ __attribute__((aligned(16))) unsigned char shm[];
    LAS unsigned char* lds = (LAS unsigned char*)shm;
    cg::grid_group grid = cg::this_grid();
    const int bid = blockIdx.x, nb = gridDim.x;
    volatile LAS unsigned* bst = (volatile LAS unsigned*)(lds + 131072);
    if (threadIdx.x < 2) bst[threadIdx.x] = 0u;
    __syncthreads();
    const XcdBarrier xbar = xcd_barrier_post((unsigned*)(ld_params().ws + OFF_BAR), bst);
    if (threadIdx.x == 0) {
        unsigned* bw = (unsigned*)(ld_params().ws + OFF_BAR);
        const unsigned xcc = xb_xcc_id(); const unsigned r = xb_add(&bw[3600 + xcc], 1u);
        unsigned ov = 0u; if (xcc >= 8u || r >= 32u) ov = xb_add(&bw[3620], 1u) + 1u;
        bst[2] = xcc; bst[3] = r; bst[4] = ov; }
#define GRID_SYNC() do { if (coop == 2) grid.sync(); else xcd_barrier(xbar); } while (0)
    const int gw = bid * 8 + (threadIdx.x >> 6), nw = nb * 8;
#ifndef REP_MASK
#define REP_MASK 0ull
#endif
#ifndef EXTRA_SYNCS
#define EXTRA_SYNCS 0
#endif
#define PH_REPS(n) (1 + (int)(((REP_MASK) >> (4 * (n))) & 15ull))
#define PH_BEGIN(n) if (PH_ON(n) && ph_lo <= (n) && (n) < ph_hi) for (int rep_ = 0; rep_ < PH_REPS(n); ++rep_) { const bool dry = rep_ > 0; (void)dry; if (rep_ > 0 && coop) GRID_SYNC(); const Params p = ld_params();
#define PH_END(n) } if (coop && ph_lo <= (n) && (n) + 1 < ph_hi) GRID_SYNC();
        PH_BEGIN(0) phase_prep(p, lds, bid, nb); PH_END(0)
        PH_BEGIN(1) phase_mod0(p, lds, bid, nb); PH_END(1)
        PH_BEGIN(2) { pg8::Gemm g{(const bf16_t*)(p.ws + OFF_XM), (const bf16_t*)(p.ws + OFF_WINE), 2048, 2048, 2048, 0, PG8_ALIGN};
                  pg8::Sched S{1, 32, 28, 896, nb, bid}; pg8::Epi E{}; E.mode = 0; E.O = (bf16_t*)(p.ws + OFF_PROJ); E.ldc = 7168;
                  pg8::gemm_phase(lds, g, S, E);
                  { const int first = nb == 256 ? 176 : 0, nconv = nb - first;
                    if (bid >= first) { __syncthreads(); tr_loop(p, lds, 1, bid - first, 1024, nconv); } } } PH_END(2)
        PH_BEGIN(3) phase_conv(p, lds, bid, nb); PH_END(3)
        PH_BEGIN(4) phase_scan(p, lds, bid, nb, dry); __syncthreads(); phase_intra(p, lds, bid, nb); PH_END(4)
        PH_BEGIN(6) if (bid < 128) { pg8::Gemm g{(const bf16_t*)(p.ws + OFF_R), (const bf16_t*)(p.ws + OFF_POOLW), 1024, 256, 256, 256, 0};
                  pg8::Sched S{2, 32, 4, 128, 128, bid}; pg8::Epi E{}; E.mode = 1; E.O = (bf16_t*)(p.ws + OFF_QK); E.ldc = 2048; E.zsrc = (const bf16_t*)(p.ws + OFF_PROJ); E.pscale = p.pool_scale;
                  pg8::gemm_phase(lds, g, S, E); }
                else phase_mout(p, 0, 32768, (bid - 128) * 8 + (threadIdx.x >> 6), (nb - 128) * 8);
                PH_END(6)
        PH_BEGIN(7) { pg8::Gemm g{(const bf16_t*)(p.ws + OFF_QK), (const bf16_t*)(p.ws + OFF_WOUTE), 2048, 2048, 2048, 0, 0};
                  pg8::Sched S{0, 32, 8, 256, nb, bid}; pg8::Epi E{}; E.mode = 2; E.xres = p.x; E.gate = (const float*)(p.ws + OFF_MOD); E.out = p.out;
                  E.lng = p.pln_g; E.lnb = p.pln_b; E.mod1 = (const float*)(p.ws + OFF_MOD) + 5 * 6144; E.xm1 = (bf16_t*)(p.ws + OFF_XM); E.rstat = (float*)(p.ws + OFF_RSTAT); E.xb = &xbar;
                  pg8::gemm_phase(lds, g, S, E); } PH_END(7)
        PH_BEGIN(9) { pg8::Gemm g{(const bf16_t*)(p.ws + OFF_XM), (const bf16_t*)(p.ws + OFF_WINO), 2048, 2048, 2048, 0, PG8_ALIGN};
                  pg8::Sched S{0, 32, 24, 768, nb, bid}; pg8::Epi E{}; E.mode = 3; E.O = (bf16_t*)(p.ws + OFF_PROJ); E.O2 = (bf16_t*)(p.ws + OFF_PROJ) + (size_t)8192 * 2048; E.ldc = 2048; E.rs2 = (float*)(p.ws + OFF_RS2);
                  pg8::gemm_phase(lds, g, S, E); } PH_END(9)
        PH_BEGIN(11) phase_sgu(p, lds, bid, nb); PH_END(11)
        PH_BEGIN(12) { pg8::Gemm g{(const bf16_t*)(p.ws + OFF_QK), (const bf16_t*)(p.ws + OFF_WOUTO), 2048, 2048, 2048, 0, 0};
                  pg8::Sched S{0, 32, 8, 256, nb, bid}; pg8::Epi E{}; E.mode = 2; E.xres = p.out; E.gate = (const float*)(p.ws + OFF_MOD) + 5 * 6144; E.out = p.out;
                  E.lng = p.pln_g + 2048; E.lnb = p.pln_b + 2048; E.mod1 = nullptr; E.xm1 = nullptr; E.rstat = (float*)(p.ws + OFF_RSTAT); E.xb = &xbar;
                  pg8::gemm_phase(lds, g, S, E); } PH_END(12)
        if (coop) for (int es_ = 0; es_ < EXTRA_SYNCS; ++es_) GRID_SYNC();
}

#ifndef MK_SPLIT
#define MK_SPLIT 0
#endif
extern "C" void kernel_launch(void* const* d_in, const int* in_sizes, int n_in, void* d_out, int out_size, void* d_ws, size_t ws_size, hipStream_t stream) {
    constexpr int LDS_BYTES = 131072 + 256;
    static int grid = 0;
    if (grid == 0) {
        if (n_in != 22 || out_size != 8192 * 2048 || ws_size < WS_END) { fprintf(stderr, "kernel_launch: unexpected shapes (n_in %d out %d ws %zu need %zu)\n", n_in, out_size, ws_size, (size_t)WS_END); grid = -1; return; }
        int dev = 0, cus = 0, per_cu = 0;
        hipGetDevice(&dev); hipDeviceGetAttribute(&cus, hipDeviceAttributeMultiprocessorCount, dev);
        if (hipFuncSetAttribute((const void*)fwd_megakernel, hipFuncAttributeMaxDynamicSharedMemorySize, LDS_BYTES) != hipSuccess) { fprintf(stderr, "kernel_launch: hipFuncSetAttribute failed\n"); grid = -1; return; }
        hipOccupancyMaxActiveBlocksPerMultiprocessor(&per_cu, (const void*)fwd_megakernel, 512, LDS_BYTES);
        (void)hipGetLastError();
        if (per_cu < 1) per_cu = 1;
        grid = cus;
        if (grid < 256) fprintf(stderr, "kernel_launch: only %d CUs; this kernel wants 256\n", grid);
        if (grid > 256) grid = 256;
    }
    if (grid < 0) return;
    Params p{};
    const float** pp = (const float**)&p;
    for (int i = 0; i < 22; ++i) pp[i] = (const float*)d_in[i];
    p.out = (float*)d_out; p.ws = (unsigned char*)d_ws;
    if (hipMemsetAsync((char*)d_ws + OFF_BAR, 0, 16384, stream) != hipSuccess) { fprintf(stderr, "kernel_launch: memset of barrier words failed\n"); return; }
#if MK_SPLIT
    for (int ph = 0; ph < 13; ++ph) { int lo = ph, hi = ph + 1, coop = 0; hipLaunchKernelGGL(fwd_megakernel, dim3(grid), dim3(512), LDS_BYTES, stream, p, lo, hi, coop); }
#else
    int lo = 0, hi = 13, coop = 1;
    void* args[] = {&p, &lo, &hi, &coop};
    hipError_t e = hipLaunchCooperativeKernel((const void*)fwd_megakernel, dim3(grid), dim3(512), args, LDS_BYTES, stream);
    if (e != hipSuccess) fprintf(stderr, "cooperative launch failed: %s (grid %d)\n", hipGetErrorString(e), grid);
#endif
}
```

```cpp
#include <hip/hip_runtime.h>
#include <hip/hip_cooperative_groups.h>
#include <cstdio>
#include <cstdint>
namespace cg = cooperative_groups;

#define LAS __attribute__((address_space(3)))
typedef unsigned short bf16_t;
typedef short bf16x8 __attribute__((ext_vector_type(8)));
typedef float f32x4 __attribute__((ext_vector_type(4)));
typedef unsigned u32x4 __attribute__((ext_vector_type(4)));
typedef unsigned u32x2 __attribute__((ext_vector_type(2)));

constexpr size_t OFF_MODP  = 0;
constexpr size_t OFF_MOD   = OFF_MODP + 8ull * 2 * 5 * 6144 * 4;
constexpr size_t OFF_GATES = OFF_MOD + 2ull * 5 * 6144 * 4;
constexpr size_t OFF_GA    = OFF_GATES + 9216ull * 16 * 4;
constexpr size_t OFF_GP    = OFF_GA + 8ull * 9216 * 4;
constexpr size_t OFF_GB    = OFF_GP + 8ull * 9216 * 4;
constexpr size_t OFF_BL    = OFF_GB + 8ull * 9216 * 4;
constexpr size_t OFF_PX    = OFF_BL + 8ull * 144 * 4 + 512;
constexpr size_t OFF_KSUM  = OFF_PX + 8ull * 144 * 4 + 512;
constexpr size_t OFF_GAM   = OFF_KSUM + 2ull * 144 * 4 * 256 * 4;
constexpr size_t OFF_WINE  = (OFF_GAM + 8ull * 8192 * 4 + 4095) & ~4095ull;
constexpr size_t OFF_WOUTE = OFF_WINE + 7168ull * 2048 * 2;
constexpr size_t OFF_WINO  = OFF_WOUTE + 2048ull * 2048 * 2;
constexpr size_t OFF_WOUTO = OFF_WINO + 6144ull * 2048 * 2;
constexpr size_t OFF_POOLW = OFF_WOUTO + 2048ull * 2048 * 2;
constexpr size_t OFF_WSP   = OFF_POOLW + 4ull * 256 * 256 * 2;
constexpr size_t OFF_XM    = OFF_WSP + 8ull * 128 * 128 * 2;
constexpr size_t OFF_PROJ  = OFF_XM + 9216ull * 2048 * 2;
constexpr size_t OFF_QK    = OFF_PROJ + 9216ull * 7168 * 2;
constexpr size_t OFF_H     = OFF_QK + 9216ull * 2048 * 2;
constexpr size_t OFF_VT    = OFF_H + 2ull * 8192 * 1024 * 4;
constexpr size_t OFF_R     = OFF_VT + 144ull * 4 * 256 * 64 * 2;
constexpr size_t OFF_BAR   = OFF_R + 8192ull * 1024 * 2;
constexpr size_t OFF_RSTAT = OFF_BAR + 16384;
constexpr size_t OFF_RS2   = OFF_RSTAT + 8192ull * 16 * 4;
constexpr size_t WS_END    = OFF_RS2 + 8192ull * 64 * 4;

struct Params {
    const float *x, *c, *ctx, *cctx, *ada_w, *ada_b, *pln_g, *pln_b, *w_in_even, *conv_qk, *b_ig, *b_fg, *mh_g, *pool_w, *pool_scale,
        *w_out_even, *w_in_odd, *sgu_g, *sgu_b, *w_sp, *b_sp, *w_out_odd;
    float* out; unsigned char* ws;
};

__device__ __forceinline__ unsigned cvt_pk_bf16(float lo, float hi) { unsigned r; asm volatile("v_cvt_pk_bf16_f32 %0, %1, %2" : "=v"(r) : "v"(lo), "v"(hi)); return r; }
__device__ __forceinline__ float bflo(unsigned w) { return __uint_as_float(w << 16); }
__device__ __forceinline__ float bfhi(unsigned w) { return __uint_as_float(w & 0xffff0000u); }
__device__ __forceinline__ float bf1(bf16_t v) { return __uint_as_float(((unsigned)v) << 16); }
__device__ __forceinline__ bf16_t f2bf(float f) { unsigned u = __float_as_uint(f); return (bf16_t)((u + 0x7fffu + ((u >> 16) & 1u)) >> 16); }
__device__ __forceinline__ float silu_f(float x) { return x * __builtin_amdgcn_rcpf(1.f + __expf(-x)); }
__device__ __forceinline__ float sigm_f(float x) { return __builtin_amdgcn_rcpf(1.f + __expf(-x)); }
__device__ __forceinline__ void unpack8(const u32x4 w, float* f) { f[0] = bflo(w[0]); f[1] = bfhi(w[0]); f[2] = bflo(w[1]); f[3] = bfhi(w[1]); f[4] = bflo(w[2]); f[5] = bfhi(w[2]); f[6] = bflo(w[3]); f[7] = bfhi(w[3]); }
__device__ __forceinline__ u32x4 pack8(const float* f) { u32x4 w; w[0] = cvt_pk_bf16(f[0], f[1]); w[1] = cvt_pk_bf16(f[2], f[3]); w[2] = cvt_pk_bf16(f[4], f[5]); w[3] = cvt_pk_bf16(f[6], f[7]); return w; }
__device__ __forceinline__ bf16x8 ldfrag(const LAS bf16_t* base, int stride, int row, int kc) { return *(const LAS bf16x8*)(base + row * stride + kc); }
#define MFMA16(a, b, c) __builtin_amdgcn_mfma_f32_16x16x32_bf16(a, b, c, 0, 0, 0)
template <int CTRL> __device__ __forceinline__ float dpp_mov(float x) { return __builtin_bit_cast(float, __builtin_amdgcn_update_dpp(0, __builtin_bit_cast(int, x), CTRL, 0xf, 0xf, false)); }
__device__ __forceinline__ float rows_sum(float x) {
    { auto r = __builtin_amdgcn_permlane16_swap(__builtin_bit_cast(unsigned, x), __builtin_bit_cast(unsigned, x), false, false); x = __builtin_bit_cast(float, (unsigned)r[0]) + __builtin_bit_cast(float, (unsigned)r[1]); }
    { auto r = __builtin_amdgcn_permlane32_swap(__builtin_bit_cast(unsigned, x), __builtin_bit_cast(unsigned, x), false, false); x = __builtin_bit_cast(float, (unsigned)r[0]) + __builtin_bit_cast(float, (unsigned)r[1]); }
    return x;
}
__device__ __forceinline__ float wave_sum(float x) {
    x += dpp_mov<0xB1>(x);
    x += dpp_mov<0x4E>(x);
    x += dpp_mov<0x141>(x);
    x += dpp_mov<0x140>(x);
    const int xi = __builtin_bit_cast(int, x);
    const float r0 = __builtin_bit_cast(float, __builtin_amdgcn_readlane(xi, 0)), r1 = __builtin_bit_cast(float, __builtin_amdgcn_readlane(xi, 16));
    const float r2 = __builtin_bit_cast(float, __builtin_amdgcn_readlane(xi, 32)), r3 = __builtin_bit_cast(float, __builtin_amdgcn_readlane(xi, 48));
    return (r0 + r1) + (r2 + r3);
}

#define XB_TMO      128
#define XB_XCNT(j)  (256  + 64 * (j))
#define XB_XSUB(j)  (1280 + 64 * (j))
#define XB_XGEN(j)  (2304 + 64 * (j))
#define XB_TOP      3328
#define XB_TOPGEN   3392
#define XCD_BAR_WORDS 3456
#define XB_SPIN_CAP (1u << 18)
__device__ __forceinline__ unsigned xb_ld(unsigned* p)              { return __hip_atomic_load(p, __ATOMIC_RELAXED, __HIP_MEMORY_SCOPE_AGENT); }
__device__ __forceinline__ unsigned xb_add(unsigned* p, unsigned v) { return __hip_atomic_fetch_add(p, v, __ATOMIC_RELAXED, __HIP_MEMORY_SCOPE_AGENT); }
__device__ __forceinline__ unsigned xb_xcc_id() { return (unsigned)__builtin_amdgcn_s_getreg((3 << 11) | 20) & 0xFu; }
#define XB_SPIN(cond, bar) do { unsigned _sp = 0; while (cond) { __builtin_amdgcn_s_sleep(1); \
    if ((++_sp & 255u) == 0u) { if (xb_ld(&(bar)[XB_TMO])) break; if (_sp > XB_SPIN_CAP) { atomicAdd(&(bar)[XB_TMO], 1u); break; } } } } while (0)

struct XcdBarrier {
    unsigned* bar; unsigned x;
    volatile LAS unsigned* st;
};

__device__ __forceinline__ XcdBarrier xcd_barrier_post(unsigned* bar, volatile LAS unsigned* st) {
    XcdBarrier b; b.bar = bar; b.x = xb_xcc_id(); b.st = st;
    if (threadIdx.x == 0) (void)xb_add(&bar[XB_XCNT(b.x)], 1u);
    return b;
}
__device__ __forceinline__ void xcd_barrier_complete(unsigned* bar, unsigned x, unsigned& nloc, unsigned& nx) {
    const unsigned G = gridDim.x * gridDim.y * gridDim.z;
    unsigned sum, cnt, mine, sp = 0u;
    for (;;) {
        sum = 0u; cnt = 0u; mine = 0u;
#pragma unroll
        for (unsigned j = 0; j < 16; ++j) { const unsigned c = xb_ld(&bar[XB_XCNT(j)]); sum += c; cnt += (c > 0u) ? 1u : 0u; mine = (j == x) ? c : mine; }
        if (sum == G) break;
        __builtin_amdgcn_s_sleep(1);
        if ((++sp & 255u) == 0u) { if (xb_ld(&bar[XB_TMO])) break; if (sp > XB_SPIN_CAP) { atomicAdd(&bar[XB_TMO], 1u); break; } }
    }
    nloc = mine > 0u ? mine : 1u; nx = cnt > 0u ? cnt : 1u;
}

__device__ __forceinline__ void xcd_barrier(const XcdBarrier& b) {
    asm volatile("s_waitcnt vmcnt(0)" ::: "memory");
    __syncthreads();
    if (threadIdx.x == 0) {
        unsigned* bar = b.bar;
        __builtin_amdgcn_s_waitcnt(0);
        unsigned nloc = b.st[0], nx = b.st[1];
        if (nloc == 0u) { xcd_barrier_complete(bar, b.x, nloc, nx); b.st[0] = nloc; b.st[1] = nx; }
        const unsigned old = xb_add(&bar[XB_XSUB(b.x)], 1u);
        const unsigned gen = old / nloc;
        if (old + 1u == (gen + 1u) * nloc) {
            __builtin_amdgcn_fence(__ATOMIC_RELEASE, "agent");
            asm volatile("s_waitcnt vmcnt(0)" ::: "memory");
            const unsigned og = xb_add(&bar[XB_TOP], 1u);
            const unsigned tg = og / nx;
            if (og + 1u == (tg + 1u) * nx) xb_add(&bar[XB_TOPGEN], 1u);
            else XB_SPIN(xb_ld(&bar[XB_TOPGEN]) == tg, bar);
            __builtin_amdgcn_fence(__ATOMIC_ACQUIRE, "agent");
            xb_add(&bar[XB_XGEN(b.x)], 1u);
            asm volatile("s_waitcnt vmcnt(0)" ::: "memory");
        } else {
            XB_SPIN(xb_ld(&bar[XB_XGEN(b.x)]) == gen, bar);
            __builtin_amdgcn_fence(__ATOMIC_ACQUIRE, "agent");
            asm volatile("s_waitcnt vmcnt(0)" ::: "memory");
        }
    }
    __syncthreads();
}

#ifndef PG8_SP2
#define PG8_SP2 1
#endif
#ifndef PG8_ALIGN
#define PG8_ALIGN 1
#endif
namespace pg8 {
constexpr int BM = 256, BK = 64, HALF = 128, HTB = HALF * BK * 2, STAGE_BYTES = 8 * HTB, NXCD = 8, WGM = 8;
__device__ __forceinline__ int lds_byte(int r, int c) { const int st = (r >> 4) * 2 + (c >> 5), rr = r & 15, cc = c & 31, ob = rr * 64 + cc * 2; return st * 1024 + (ob ^ (((ob >> 9) & 1) << 5)); }
__device__ __forceinline__ void stage_rc(int b, int& R, int& C) { const int st = b / 1024, sb = b % 1024, swz = sb ^ (((sb >> 9) & 1) << 5); R = (st >> 1) * 16 + swz / 64; C = (st & 1) * 32 + (swz % 64) / 2; }
__device__ __forceinline__ int perm32(int rho) { const int n = rho >> 4, i = rho & 15; return 8 * (i >> 2) + 4 * n + (i & 3); }
struct Unit { int pm, pn; };
struct Gemm { const bf16_t* A; const bf16_t* Bt; int lda, ldb, K, acol; int align; };
struct Sched {
    int mode, nM, nN, nwg, G, c;
    __device__ __forceinline__ bool next(int i, Unit& u) const {
        const int L = i * G + c;
        if (mode == 2) { if (L >= 128) return false; u.pm = L & 31; u.pn = L >> 5; return true; }
        if (L >= nwg + (mode == 1 ? 32 : 0)) return false;
        if (L >= nwg) { const int e = L - nwg; u.pm = 32 + (e & 3); u.pn = 4 + (e >> 2); return true; }
        int wgid = L; { const int q = nwg / NXCD, r = nwg % NXCD, xcd = wgid % NXCD, off = wgid / NXCD; wgid = (xcd < r ? xcd * (q + 1) : r * (q + 1) + (xcd - r) * q) + off; }
        const int nig = WGM * nN, gid = wgid / nig, fm = gid * WGM, gsz = (nM - fm) < WGM ? (nM - fm) : WGM;
        u.pm = fm + ((wgid % nig) % gsz); u.pn = (wgid % nig) / gsz; return true;
    }
};
struct Epi {
    int mode;
    bf16_t* O; int ldc;
    bf16_t* O2;
    float* rs2;
    const bf16_t* zsrc; const float* pscale;
    const float* xres; const float* gate; float* out;
    const float* lng; const float* lnb; const float* mod1; bf16_t* xm1; float* rstat; const XcdBarrier* xb;
    __device__ __forceinline__ void fused_ln(f32x4 (&acc)[2][2][4][2], const Unit& u, int wr, int wc, int fr, int fq, LAS unsigned char* lds) const {
        asm volatile("" : "+v"(fr), "+v"(fq));
        const int tid = threadIdx.x;
        LAS float* part = (LAS float*)lds;
        LAS float* st = (LAS float*)(lds + 8192);
        const int row0 = u.pm * BM + wr * 64 + fr, col0 = u.pn * BM + wc * 32 + 8 * fq; const int b = (u.pm * BM) >> 11;
        { f32x4 gv[2][2];
#pragma unroll
          for (int bj = 0; bj < 2; ++bj)
#pragma unroll
              for (int n = 0; n < 2; ++n) gv[bj][n] = *(const f32x4*)(gate + (size_t)b * 6144 + 4096 + col0 + bj * HALF + n * 4);
#pragma unroll
          for (int ai = 0; ai < 2; ++ai)
#pragma unroll
              for (int m = 0; m < 4; ++m) { const size_t off = (size_t)(row0 + ai * HALF + m * 16) * 2048 + col0; float s = 0.f, q = 0.f;
#pragma unroll
                  for (int bj = 0; bj < 2; ++bj)
#pragma unroll
                      for (int n = 0; n < 2; ++n) { const f32x4 xr = __builtin_nontemporal_load((const f32x4*)(xres + off + bj * HALF + n * 4));
                          const f32x4 t = xr * 1.41421356237f + gv[bj][n] * acc[ai][bj][m][n]; acc[ai][bj][m][n] = t;
                          s += (t[0] + t[1]) + (t[2] + t[3]); q += (t[0] * t[0] + t[1] * t[1]) + (t[2] * t[2] + t[3] * t[3]); }
                  s = rows_sum(s); q = rows_sum(q);
                  if (fq == 0) { const int rl = ai * HALF + wr * 64 + m * 16 + fr; part[(wc * 256 + rl) * 2] = s; part[(wc * 256 + rl) * 2 + 1] = q; }
                  if (m & 1) asm volatile("" ::: "memory"); } }
        __syncthreads();
        if (tid < 256) { const float s = (part[tid * 2] + part[(256 + tid) * 2]) + (part[(512 + tid) * 2] + part[(768 + tid) * 2]);
            const float q = (part[tid * 2 + 1] + part[(256 + tid) * 2 + 1]) + (part[(512 + tid) * 2 + 1] + part[(768 + tid) * 2 + 1]);
            float* dst = rstat + ((size_t)(u.pm * BM + tid) * 8 + u.pn) * 2; dst[0] = s; dst[1] = q; }
        xcd_barrier(*xb);
        if (tid < 256) { const float* src = rstat + (size_t)(u.pm * BM + tid) * 16; float s = 0.f, q = 0.f;
#pragma unroll
            for (int j = 0; j < 8; ++j) { s += src[2 * j]; q += src[2 * j + 1]; }
            const float mu = s * (1.f / 2048.f); const float var = fmaxf(q * (1.f / 2048.f) - mu * mu, 0.f);
            st[tid * 2] = mu; st[tid * 2 + 1] = rsqrtf(var + 1e-5f); }
        __syncthreads();
        { f32x4 lg[2][2], lb[2][2];
#pragma unroll
          for (int bj = 0; bj < 2; ++bj)
#pragma unroll
              for (int n = 0; n < 2; ++n) { lg[bj][n] = *(const f32x4*)(lng + col0 + bj * HALF + n * 4); lb[bj][n] = *(const f32x4*)(lnb + col0 + bj * HALF + n * 4); }
          f32x4 msh[2][2], msc[2][2];
#pragma unroll
          for (int bj = 0; bj < 2; ++bj)
#pragma unroll
              for (int n = 0; n < 2; ++n) { if (xm1) { const float* mp = mod1 + (size_t)b * 6144 + col0 + bj * HALF + n * 4; msh[bj][n] = *(const f32x4*)mp; msc[bj][n] = *(const f32x4*)(mp + 2048) + 1.f; }
                  else { msh[bj][n] = (f32x4){0.f, 0.f, 0.f, 0.f}; msc[bj][n] = msh[bj][n]; } }
#pragma unroll
          for (int ai = 0; ai < 2; ++ai)
#pragma unroll
              for (int m = 0; m < 4; ++m) { const int rl = ai * HALF + wr * 64 + m * 16 + fr; const float mu = st[rl * 2], rs = st[rl * 2 + 1];
                  const size_t off = (size_t)(row0 + ai * HALF + m * 16) * 2048 + col0;
#pragma unroll
                  for (int bj = 0; bj < 2; ++bj) { f32x4 y[2];
#pragma unroll
                      for (int n = 0; n < 2; ++n) { y[n] = (acc[ai][bj][m][n] - mu) * rs * lg[bj][n] + lb[bj][n]; *(f32x4*)(out + off + bj * HALF + n * 4) = y[n]; }
                      if (xm1) { const f32x4 x0 = y[0] * msc[bj][0] + msh[bj][0], x1 = y[1] * msc[bj][1] + msh[bj][1];
                          u32x4 w; w[0] = cvt_pk_bf16(x0[0], x0[1]); w[1] = cvt_pk_bf16(x0[2], x0[3]); w[2] = cvt_pk_bf16(x1[0], x1[1]); w[3] = cvt_pk_bf16(x1[2], x1[3]);
                          *(u32x4*)(xm1 + off + bj * HALF) = w; } }
                  asm volatile("" ::: "memory"); } }
    }
    __device__ __forceinline__ void operator()(const f32x4 (&acc)[2][2][4][2], const Unit& u, int wr, int wc, int fr, int fq) const {
        asm volatile("" : "+v"(fr), "+v"(fq));
        if (mode == 0) {
            const int row0 = u.pm * BM + wr * 64 + fr, col0 = u.pn * BM + wc * 32 + 8 * fq;
#pragma unroll
            for (int ai = 0; ai < 2; ++ai)
#pragma unroll
                for (int m = 0; m < 4; ++m) { bf16_t* rowp = O + (size_t)(row0 + ai * HALF + m * 16) * ldc + col0; float ss = 0.f, qq = 0.f;
#pragma unroll
                    for (int bj = 0; bj < 2; ++bj) { const f32x4 v0 = acc[ai][bj][m][0], v1 = acc[ai][bj][m][1];
                        u32x4 w; w[0] = cvt_pk_bf16(v0[0], v0[1]); w[1] = cvt_pk_bf16(v0[2], v0[3]); w[2] = cvt_pk_bf16(v1[0], v1[1]); w[3] = cvt_pk_bf16(v1[2], v1[3]);
                        *(u32x4*)(rowp + bj * HALF) = w;
                        ss += ((v0[0] + v0[1]) + (v0[2] + v0[3])) + ((v1[0] + v1[1]) + (v1[2] + v1[3]));
                        qq += ((v0[0] * v0[0] + v0[1] * v0[1]) + (v0[2] * v0[2] + v0[3] * v0[3])) + ((v1[0] * v1[0] + v1[1] * v1[1]) + (v1[2] * v1[2] + v1[3] * v1[3])); }
                    if (rs2 && (u.pn >> 3) == 1) { ss += __shfl_xor(ss, 16); qq += __shfl_xor(qq, 16); ss += __shfl_xor(ss, 32); qq += __shfl_xor(qq, 32);
                        if (fq == 0) { float* d = rs2 + ((size_t)(row0 + ai * HALF + m * 16) * 32 + (u.pn - 8) * 4 + wc) * 2; d[0] = ss; d[1] = qq; } } }
        } else if (mode == 3) {
            const int row0 = u.pm * BM + wr * 64 + fr;
            if (u.pn < 16) { const int col0 = u.pn * 128 + wc * 32 + 8 * fq;
#pragma unroll
                for (int ai = 0; ai < 2; ++ai)
#pragma unroll
                    for (int m = 0; m < 4; ++m) { const f32x4 u0 = acc[ai][0][m][0], u1 = acc[ai][0][m][1], z0 = acc[ai][1][m][0], z1 = acc[ai][1][m][1]; float o[8];
#pragma unroll
                        for (int q = 0; q < 4; ++q) { o[q] = u0[q] * silu_f(z0[q]); o[4 + q] = u1[q] * silu_f(z1[q]); }
                        *(u32x4*)(O + (size_t)(row0 + ai * HALF + m * 16) * 2048 + col0) = pack8(o); }
            } else { const int col0 = (u.pn - 16) * BM + wc * 32 + 8 * fq;
#pragma unroll
                for (int ai = 0; ai < 2; ++ai)
#pragma unroll
                    for (int m = 0; m < 4; ++m) { bf16_t* rowp = O2 + (size_t)(row0 + ai * HALF + m * 16) * 2048 + col0; float ss = 0.f, qq = 0.f;
#pragma unroll
                        for (int bj = 0; bj < 2; ++bj) { const f32x4 v0 = acc[ai][bj][m][0], v1 = acc[ai][bj][m][1];
                            u32x4 w; w[0] = cvt_pk_bf16(v0[0], v0[1]); w[1] = cvt_pk_bf16(v0[2], v0[3]); w[2] = cvt_pk_bf16(v1[0], v1[1]); w[3] = cvt_pk_bf16(v1[2], v1[3]);
                            *(u32x4*)(rowp + bj * HALF) = w;
                            ss += ((v0[0] + v0[1]) + (v0[2] + v0[3])) + ((v1[0] + v1[1]) + (v1[2] + v1[3]));
                            qq += ((v0[0] * v0[0] + v0[1] * v0[1]) + (v0[2] * v0[2] + v0[3] * v0[3])) + ((v1[0] * v1[0] + v1[1] * v1[1]) + (v1[2] * v1[2] + v1[3] * v1[3])); }
                        ss = rows_sum(ss); qq = rows_sum(qq);
                        if (fq == 0) { float* d = rs2 + ((size_t)(row0 + ai * HALF + m * 16) * 32 + (u.pn - 16) * 4 + wc) * 2; d[0] = ss; d[1] = qq; } } }
        } else if (mode == 1) {
            const int g = u.pn; const int row0 = u.pm * BM + wr * 64 + fr, cg0 = wc * 32 + 8 * fq;
#pragma unroll
            for (int bj = 0; bj < 2; ++bj) { const int cg = cg0 + bj * HALF;
                const f32x4 ps0 = *(const f32x4*)(pscale + g * 256 + cg), ps1 = *(const f32x4*)(pscale + g * 256 + cg + 4);
#pragma unroll
                for (int ai = 0; ai < 2; ++ai)
#pragma unroll
                    for (int m = 0; m < 4; ++m) { const size_t row = (size_t)(row0 + ai * HALF + m * 16);
                        const u32x4 zw = *(const u32x4*)(zsrc + row * 7168 + 6144 + g * 256 + cg); float z[8]; unpack8(zw, z);
                        const f32x4 v0 = acc[ai][bj][m][0], v1 = acc[ai][bj][m][1]; float o[8];
#pragma unroll
                        for (int q = 0; q < 4; ++q) { o[q] = v0[q] * ps0[q] * silu_f(z[q]); o[4 + q] = v1[q] * ps1[q] * silu_f(z[4 + q]); }
                        *(u32x4*)(O + row * 2048 + 1024 + g * 256 + cg) = pack8(o);
                        if (m == 3) asm volatile("" ::: "memory"); } }
        } else {
            const int row0 = u.pm * BM + wr * 64 + fr, col0 = u.pn * BM + wc * 32 + 8 * fq; const int b = (u.pm * BM) >> 11;
            f32x4 gv[2][2];
#pragma unroll
            for (int bj = 0; bj < 2; ++bj)
#pragma unroll
                for (int n = 0; n < 2; ++n) gv[bj][n] = *(const f32x4*)(gate + (size_t)b * 6144 + 4096 + col0 + bj * HALF + n * 4);
#pragma unroll
            for (int ai = 0; ai < 2; ++ai)
#pragma unroll
                for (int m = 0; m < 4; ++m) { const size_t off = (size_t)(row0 + ai * HALF + m * 16) * 2048 + col0;
#pragma unroll
                    for (int bj = 0; bj < 2; ++bj)
#pragma unroll
                        for (int n = 0; n < 2; ++n) { const f32x4 xr = *(const f32x4*)(xres + off + bj * HALF + n * 4);
                            *(f32x4*)(out + off + bj * HALF + n * 4) = xr * 1.41421356237f + gv[bj][n] * acc[ai][bj][m][n]; } }
        }
    }
};

__device__ __forceinline__ void gemm_phase(LAS unsigned char* lds, const Gemm g, const Sched& S, const Epi& E) {
    const int tid = threadIdx.x, wid = __builtin_amdgcn_readfirstlane(tid >> 6), lane = tid & 63, wr = wid >> 2, wc = wid & 3, fr = lane & 15, fq = lane >> 4;
    const int K = g.K, nt = K / BK; const bool perm = true;
    unsigned voffA[2], voffB[2];
#pragma unroll
    for (int i = 0; i < 2; ++i) { int R, C; stage_rc(tid * 16 + i * 8192, R, C); const int Rb = perm ? ((R & ~31) + perm32(R & 31)) : R;
        voffA[i] = (unsigned)(R * g.lda + C) * 2u; voffB[i] = (unsigned)(Rb * g.ldb + C) * 2u; }
    const size_t kstep = (size_t)(BK * 2);
    const size_t hstepA = (size_t)HALF * g.lda * 2, hstepB = (size_t)HALF * g.ldb * 2;
    const unsigned ldsw = (unsigned)wid * 1024u;
    const int aoff = lds_byte(wr * 64 + fr, fq * 8), boff = lds_byte(wc * 32 + fr, fq * 8);
#define PG8_SA(b, h) (((b) * 2 + (h)) * HTB)
#define PG8_SB(b, h) ((4 + (b) * 2 + (h)) * HTB)
#define PG8_STAGE(bufoff, gbase, voff) do { _Pragma("unroll") for (int _i = 0; _i < 2; ++_i) \
        __builtin_amdgcn_global_load_lds((const unsigned*)((const char*)(gbase) + (voff)[_i]), (LAS unsigned*)(lds + (bufoff) + ldsw + _i * 8192), 16, 0, 0); } while (0)
#define PG8_LDA(dst, b, h) do { _Pragma("unroll") for (int m = 0; m < 4; ++m) _Pragma("unroll") for (int k = 0; k < 2; ++k) dst[m][k] = *(const LAS bf16x8*)(lds + PG8_SA(b, h) + aoff + m * 2048 + k * 1024); } while (0)
#define PG8_LDB(dst, b, h) do { _Pragma("unroll") for (int n = 0; n < 2; ++n) _Pragma("unroll") for (int k = 0; k < 2; ++k) dst[n][k] = *(const LAS bf16x8*)(lds + PG8_SB(b, h) + boff + n * 2048 + k * 1024); } while (0)
#define PG8_MMA(ai, bj, At, Bt) do { __builtin_amdgcn_s_setprio(1); _Pragma("unroll") for (int m = 0; m < 4; ++m) _Pragma("unroll") for (int n = 0; n < 2; ++n) _Pragma("unroll") for (int k = 0; k < 2; ++k) \
        acc[ai][bj][m][n] = __builtin_amdgcn_mfma_f32_16x16x32_bf16(Bt[n][k], At[m][k], acc[ai][bj][m][n], 0, 0, 0); __builtin_amdgcn_s_setprio(0); } while (0)
#define PG8_WAIT_V(n) asm volatile("s_waitcnt vmcnt(" #n ")" ::: "memory")
#define PG8_WAIT_L(n) asm volatile("s_waitcnt lgkmcnt(" #n ")" ::: "memory")
#define PG8_BAR __builtin_amdgcn_s_barrier()
#define PG8_SCHED __builtin_amdgcn_sched_barrier(0)
#define PG8_APTR(u) ((const char*)g.A + ((size_t)(u).pm * BM * g.lda + (size_t)(u).pn * g.acol) * 2)
#define PG8_BPTR(u) ((const char*)g.Bt + (size_t)(u).pn * BM * g.ldb * 2)
    Unit cur, nxt; int ui = 0;
    if (!S.next(0, cur)) return;
    f32x4 acc[2][2][4][2];
#pragma unroll
    for (int a = 0; a < 2; ++a)
#pragma unroll
        for (int b = 0; b < 2; ++b)
#pragma unroll
            for (int m = 0; m < 4; ++m)
#pragma unroll
                for (int n = 0; n < 2; ++n) acc[a][b][m][n] = (f32x4){0.f, 0.f, 0.f, 0.f};
    bf16x8 At[4][2], B0[2][2], B1[2][2];
    const char* cA = PG8_APTR(cur); const char* cB = PG8_BPTR(cur);
#if PG8_SP2
    PG8_STAGE(PG8_SB(0, 0), cB, voffB); PG8_STAGE(PG8_SB(0, 1), cB + hstepB, voffB); PG8_STAGE(PG8_SA(0, 0), cA, voffA); PG8_STAGE(PG8_SA(0, 1), cA + hstepA, voffA);
    if (wr == 1) PG8_BAR;
    PG8_WAIT_V(2); PG8_BAR;
    PG8_STAGE(PG8_SB(1, 0), cB + kstep, voffB); PG8_STAGE(PG8_SA(1, 0), cA + kstep, voffA); PG8_STAGE(PG8_SB(1, 1), cB + hstepB + kstep, voffB);
    PG8_WAIT_V(6); PG8_BAR;
#else
    PG8_STAGE(PG8_SB(0, 0), cB, voffB); PG8_STAGE(PG8_SA(0, 0), cA, voffA); PG8_STAGE(PG8_SB(0, 1), cB + hstepB, voffB); PG8_STAGE(PG8_SA(0, 1), cA + hstepA, voffA);
    if (wr == 1) PG8_BAR;
    PG8_WAIT_V(4); PG8_BAR;
    PG8_STAGE(PG8_SB(1, 0), cB + kstep, voffB); PG8_STAGE(PG8_SA(1, 0), cA + kstep, voffA); PG8_STAGE(PG8_SB(1, 1), cB + hstepB + kstep, voffB);
    PG8_WAIT_V(6); PG8_BAR;
#endif
    for (;;) {
        const bool has_next = S.next(ui + 1, nxt);
        const char* nA = has_next ? PG8_APTR(nxt) : cA; const char* nB = has_next ? PG8_BPTR(nxt) : cB;
        for (int t = 0; t < nt; t += 2) {
            const bool last = (t == nt - 2);
            const char* a1 = cA + (size_t)(t + 1) * kstep;
            const char* a2 = last ? nA : cA + (size_t)(t + 2) * kstep; const char* b2 = last ? nB : cB + (size_t)(t + 2) * kstep;
            const char* a3 = a2 + kstep; const char* b3 = b2 + kstep;
#if PG8_SP2
            PG8_LDB(B0, 0, 0); PG8_LDB(B1, 0, 1); PG8_SCHED; PG8_LDA(At, 0, 0); PG8_STAGE(PG8_SA(1, 1), a1 + hstepA, voffA);
            PG8_WAIT_V(8); PG8_WAIT_L(0); PG8_BAR; PG8_MMA(0, 0, At, B0); PG8_MMA(0, 1, At, B1); PG8_BAR; PG8_SCHED;
            PG8_LDA(At, 0, 1); PG8_STAGE(PG8_SB(0, 0), b2, voffB); PG8_STAGE(PG8_SB(0, 1), b2 + hstepB, voffB); PG8_STAGE(PG8_SA(0, 0), a2, voffA);
            PG8_WAIT_V(8); PG8_WAIT_L(0); PG8_BAR; PG8_MMA(1, 0, At, B0); PG8_MMA(1, 1, At, B1); PG8_BAR; PG8_SCHED;
            PG8_LDB(B0, 1, 0); PG8_LDB(B1, 1, 1); PG8_SCHED; PG8_LDA(At, 1, 0); PG8_STAGE(PG8_SA(0, 1), a2 + hstepA, voffA);
            PG8_WAIT_V(8); PG8_WAIT_L(0); PG8_BAR; PG8_MMA(0, 0, At, B0); PG8_MMA(0, 1, At, B1); PG8_BAR; PG8_SCHED;
            PG8_LDA(At, 1, 1); PG8_STAGE(PG8_SB(1, 0), b3, voffB); PG8_STAGE(PG8_SB(1, 1), b3 + hstepB, voffB); PG8_STAGE(PG8_SA(1, 0), a3, voffA);
            PG8_WAIT_V(8); PG8_WAIT_L(0); PG8_BAR; PG8_MMA(1, 0, At, B0); PG8_MMA(1, 1, At, B1); PG8_BAR; PG8_SCHED;
#else
            PG8_LDB(B0, 0, 0); PG8_SCHED; PG8_LDA(At, 0, 0); PG8_STAGE(PG8_SA(1, 1), a1 + hstepA, voffA);
            PG8_WAIT_L(8); PG8_BAR; PG8_WAIT_L(0); PG8_MMA(0, 0, At, B0); PG8_BAR; PG8_SCHED;
            PG8_LDB(B1, 0, 1); PG8_STAGE(PG8_SB(0, 0), b2, voffB);
            PG8_BAR; PG8_WAIT_L(0); PG8_MMA(0, 1, At, B1); PG8_BAR;
            PG8_LDA(At, 0, 1); PG8_STAGE(PG8_SA(0, 0), a2, voffA);
            PG8_BAR; PG8_WAIT_L(0); PG8_MMA(1, 0, At, B0); PG8_BAR; PG8_SCHED;
            PG8_STAGE(PG8_SB(0, 1), b2 + hstepB, voffB);
            PG8_WAIT_V(6); PG8_BAR; PG8_MMA(1, 1, At, B1); PG8_BAR;
            PG8_LDB(B0, 1, 0); PG8_SCHED; PG8_LDA(At, 1, 0); PG8_STAGE(PG8_SA(0, 1), a2 + hstepA, voffA);
            PG8_WAIT_L(8); PG8_BAR; PG8_WAIT_L(0); PG8_MMA(0, 0, At, B0); PG8_BAR; PG8_SCHED;
            PG8_LDB(B1, 1, 1); PG8_STAGE(PG8_SB(1, 0), b3, voffB);
            PG8_BAR; PG8_WAIT_L(0); PG8_MMA(0, 1, At, B1); PG8_BAR;
            PG8_LDA(At, 1, 1); PG8_STAGE(PG8_SA(1, 0), a3, voffA);
            PG8_BAR; PG8_WAIT_L(0); PG8_MMA(1, 0, At, B0); PG8_BAR; PG8_SCHED;
            PG8_STAGE(PG8_SB(1, 1), b3 + hstepB, voffB);
            PG8_WAIT_V(6); PG8_BAR; PG8_MMA(1, 1, At, B1); PG8_BAR;
#endif
        }
        if (g.align && wr == 0) PG8_BAR;
        if (E.mode != 2) E(acc, cur, wr, wc, fr, fq);
        if (!has_next) break;
#pragma unroll
        for (int a = 0; a < 2; ++a)
#pragma unroll
            for (int b = 0; b < 2; ++b)
#pragma unroll
                for (int m = 0; m < 4; ++m)
#pragma unroll
                    for (int n = 0; n < 2; ++n) acc[a][b][m][n] = (f32x4){0.f, 0.f, 0.f, 0.f};
        cur = nxt; cA = nA; cB = nB; ++ui;
        if (g.align && wr == 1) PG8_BAR;
    }
    PG8_WAIT_V(0);
    if (!g.align && wr == 0) PG8_BAR;
    PG8_BAR;
    if (E.mode == 2) E.fused_ln(acc, cur, wr, wc, fr, fq, lds);
}
}

struct TrDesc { const float* src; bf16_t* dst; int ldsrc, lddst, k0, n0s, n0d; };
__device__ __forceinline__ TrDesc tr_desc(const Params& p, int set, int q) {
    TrDesc d; int kg;
    if (set == 0) {
        if (q < 896) { const int nt = q >> 3; kg = q & 7; d.src = p.w_in_even; d.ldsrc = 7184; d.n0d = nt * 64; d.n0s = d.n0d + (nt >= 80 ? 16 : 0); d.dst = (bf16_t*)(p.ws + OFF_WINE); d.lddst = 2048; }
        else if ((q -= 896) < 256) { const int nt = q >> 3; kg = q & 7; d.src = p.w_out_even; d.ldsrc = 2048; d.n0d = d.n0s = nt * 64; d.dst = (bf16_t*)(p.ws + OFF_WOUTE); d.lddst = 2048; }
        else { q -= 256; const int g = q >> 2, nt = q & 3; kg = 0; d.src = p.pool_w + g * 65536; d.ldsrc = 256; d.n0d = d.n0s = nt * 64; d.dst = (bf16_t*)(p.ws + OFF_POOLW) + g * 65536; d.lddst = 256; }
    } else {
        if (q < 768) { const int nt = q >> 3; kg = q & 7; d.src = p.w_in_odd; d.ldsrc = 6144; d.n0d = nt * 64; d.dst = (bf16_t*)(p.ws + OFF_WINO); d.lddst = 2048;
            const int pnp = nt >> 2, within = (nt & 3) * 64;
            d.n0s = pnp < 16 ? ((within >> 7) ? 4096 : 0) + pnp * 128 + (within & 127) : 2048 + (pnp - 16) * 256 + within; }
        else { q -= 768; const int nt = q >> 3; kg = q & 7; d.src = p.w_out_odd; d.ldsrc = 2048; d.n0d = d.n0s = nt * 64; d.dst = (bf16_t*)(p.ws + OFF_WOUTO); d.lddst = 2048; }
    }
    d.k0 = kg * 256; return d;
}
__device__ __forceinline__ void tr_loop(const Params& p, LAS unsigned char* lds, int set, int q0, int qend, int stride) {
    const int tid = threadIdx.x; LAS float* lf = (LAS float*)lds;
    const int kr = tid >> 4, c4 = tid & 15, n = tid >> 3, kseg = tid & 7;
    f32x4 v[8];
    int q = q0;
    if (q < qend) { const TrDesc d = tr_desc(p, set, q);
#pragma unroll
        for (int ps = 0; ps < 8; ++ps) v[ps] = __builtin_nontemporal_load((const f32x4*)(d.src + (size_t)(d.k0 + kr + 32 * ps) * d.ldsrc + d.n0s + c4 * 4)); }
    while (q < qend) {
#pragma unroll
        for (int ps = 0; ps < 8; ++ps)
#pragma unroll
            for (int i = 0; i < 4; ++i) lf[(kr + 32 * ps) * 65 + c4 * 4 + i] = v[ps][i];
        __syncthreads();
        const int qn = q + stride;
        if (qn < qend) { const TrDesc d = tr_desc(p, set, qn);
#pragma unroll
            for (int ps = 0; ps < 8; ++ps) v[ps] = __builtin_nontemporal_load((const f32x4*)(d.src + (size_t)(d.k0 + kr + 32 * ps) * d.ldsrc + d.n0s + c4 * 4)); }
        { const TrDesc d = tr_desc(p, set, q);
#pragma unroll
          for (int qq = 0; qq < 4; ++qq) { float f[8];
#pragma unroll
              for (int jj = 0; jj < 8; ++jj) f[jj] = lf[(kseg * 32 + qq * 8 + jj) * 65 + n];
              *(u32x4*)(d.dst + (size_t)(d.n0d + n) * d.lddst + d.k0 + kseg * 32 + qq * 8) = pack8(f); } }
        __syncthreads();
        q = qn;
    }
}

__device__ __forceinline__ void phase_prep(const Params& p, LAS unsigned char* lds, int bid, int nb) {
    const int tid = threadIdx.x;
    LAS float* lf = (LAS float*)lds;
    float* modp = (float*)(p.ws + OFF_MODP);
    constexpr int NT_ADA = 192, NT_TR = 896 + 256 + 16, NT_SP = 32;
    for (int t = bid; t < NT_ADA; t += nb) {
        {
            const int l = t / 96, jblk = (t % 96) / 8, ks = t % 8;
            for (int e = tid; e < 5 * 256; e += 512) { const int r = e >> 8, kk = e & 255, k = ks * 256 + kk; const float cv = r < 4 ? p.c[r * 2048 + k] : p.cctx[k]; lf[e] = silu_f(cv); }
            __syncthreads();
            const int sub = tid >> 7, ct = tid & 127, j = jblk * 512 + ct * 4;
            float acc[5][4];
#pragma unroll
            for (int r = 0; r < 5; ++r)
#pragma unroll
                for (int i = 0; i < 4; ++i) acc[r][i] = 0.f;
            const float* wp = p.ada_w + ((size_t)l * 2048 + ks * 256 + sub * 64) * 6144 + j;
#pragma unroll 8
            for (int kk = 0; kk < 64; ++kk) { const f32x4 w = __builtin_nontemporal_load((const f32x4*)(wp + (size_t)kk * 6144));
#pragma unroll
                for (int r = 0; r < 5; ++r) { const float s = lf[r * 256 + sub * 64 + kk];
#pragma unroll
                    for (int i = 0; i < 4; ++i) acc[r][i] += s * w[i]; } }
            __syncthreads();
            LAS float* red = lf + 2048;
#pragma unroll
            for (int r = 0; r < 5; ++r)
#pragma unroll
                for (int i = 0; i < 4; ++i) red[(sub * 5 + r) * 512 + ct * 4 + i] = acc[r][i];
            __syncthreads();
            for (int e = tid; e < 2560; e += 512) { const int r = e >> 9, jj = e & 511;
                const float s = red[(0 + r) * 512 + jj] + red[(5 + r) * 512 + jj] + red[(10 + r) * 512 + jj] + red[(15 + r) * 512 + jj];
                modp[((size_t)(ks * 2 + l) * 5 + r) * 6144 + jblk * 512 + jj] = s; }
            __syncthreads();
        }
    }
    { const int rot = (bid + nb - (NT_ADA % nb)) % nb; tr_loop(p, lds, 0, rot, NT_TR, nb); }
    for (int t = bid; t < NT_SP; t += nb) {
        {
            const int s = t; const size_t e0 = (size_t)s * 4096 + tid * 8;
            const f32x4 a = *(const f32x4*)(p.w_sp + e0), b = *(const f32x4*)(p.w_sp + e0 + 4);
            float f[8] = {a[0], a[1], a[2], a[3], b[0], b[1], b[2], b[3]};
            *(u32x4*)((bf16_t*)(p.ws + OFF_WSP) + e0) = pack8(f);
        }
    }
}

__device__ __forceinline__ void phase_mod0(const Params& p, LAS unsigned char* lds, int bid, int nb) {
    const int tid = threadIdx.x, lane = tid & 63, wid = tid >> 6;
    const float* modp = (const float*)(p.ws + OFF_MODP);
    float* mod = (float*)(p.ws + OFF_MOD);
    for (int e = bid * 512 + tid; e < 61440; e += nb * 512) { const int l = e / 30720, rem = e % 30720, r = rem / 6144, j = rem % 6144;
        float s = p.ada_b[l * 6144 + j];
#pragma unroll
        for (int ks = 0; ks < 8; ++ks) s += modp[((size_t)(ks * 2 + l) * 5 + r) * 6144 + j];
        mod[e] = s; }
    const int c0 = tid * 4;
    float wg[4][16];
#pragma unroll
    for (int i = 0; i < 4; ++i)
#pragma unroll
        for (int g4 = 0; g4 < 4; ++g4) { const f32x4 w4 = *(const f32x4*)(p.w_in_even + (size_t)(c0 + i) * 7184 + 5120 + g4 * 4);
#pragma unroll
            for (int q = 0; q < 4; ++q) wg[i][g4 * 4 + q] = w4[q]; }
    LAS float* part = (LAS float*)lds;
    bf16_t* XM = (bf16_t*)(p.ws + OFF_XM); float* GATES = (float*)(p.ws + OFF_GATES);
    for (int t = bid; t < 256; t += nb) {
        const int r0 = t * 36; int curmr = -1; float sh[4] = {0.f, 0.f, 0.f, 0.f}, sc[4] = {0.f, 0.f, 0.f, 0.f};
        f32x4 xn[4], xn2[4];
#pragma unroll
        for (int u = 0; u < 4; ++u) { const int r = r0 + u; const float* src = r < 8192 ? p.x + (size_t)r * 2048 : p.ctx + (size_t)(r - 8192) * 2048; xn[u] = __builtin_nontemporal_load((const f32x4*)(src + c0)); }
#pragma unroll
        for (int u = 0; u < 4; ++u) { const int r = r0 + 4 + u; const float* src = r < 8192 ? p.x + (size_t)r * 2048 : p.ctx + (size_t)(r - 8192) * 2048; xn2[u] = __builtin_nontemporal_load((const f32x4*)(src + c0)); }
        for (int rr = 0; rr < 36; rr += 4) {
            const int rb = r0 + rr; const int mr = rb < 8192 ? (rb >> 11) : 4;
            f32x4 xv[4];
#pragma unroll
            for (int u = 0; u < 4; ++u) { xv[u] = xn[u]; xn[u] = xn2[u]; }
            {
#pragma unroll
                for (int u = 0; u < 4; ++u) { int r = rb + 8 + u; r = r < r0 + 36 ? r : r0 + 35; const float* src = r < 8192 ? p.x + (size_t)r * 2048 : p.ctx + (size_t)(r - 8192) * 2048; xn2[u] = __builtin_nontemporal_load((const f32x4*)(src + c0)); } }
            if (mr != curmr) { curmr = mr;
#pragma unroll
                for (int i = 0; i < 4; ++i) { float a = p.ada_b[c0 + i], b2 = p.ada_b[2048 + c0 + i];
#pragma unroll
                    for (int ks = 0; ks < 8; ++ks) { a += modp[((size_t)(ks * 2) * 5 + mr) * 6144 + c0 + i]; b2 += modp[((size_t)(ks * 2) * 5 + mr) * 6144 + 2048 + c0 + i]; }
                    sh[i] = a; sc[i] = b2; } }
            float pv[4][16];
#pragma unroll
            for (int u = 0; u < 4; ++u) { float xm[4];
#pragma unroll
                for (int i = 0; i < 4; ++i) xm[i] = xv[u][i] * (1.f + sc[i]) + sh[i];
                u32x2 w; w[0] = cvt_pk_bf16(xm[0], xm[1]); w[1] = cvt_pk_bf16(xm[2], xm[3]);
                *(u32x2*)(XM + (size_t)(rb + u) * 2048 + c0) = w;
#pragma unroll
                for (int g = 0; g < 16; ++g) pv[u][g] = xm[0] * wg[0][g] + xm[1] * wg[1][g] + xm[2] * wg[2][g] + xm[3] * wg[3][g]; }
#define RS_STEP(off, n) _Pragma("unroll") for (int u = 0; u < 4; ++u) _Pragma("unroll") for (int i = 0; i < (n) / 2; ++i) { const float a_ = pv[u][i], b_ = pv[u][i + (n) / 2]; const bool up_ = (lane & (off)) != 0; \
                const float send_ = up_ ? a_ : b_, keep_ = up_ ? b_ : a_; pv[u][i] = keep_ + __shfl_xor(send_, (off)); }
            RS_STEP(32, 16) RS_STEP(16, 8) RS_STEP(8, 4) RS_STEP(4, 2)
#undef RS_STEP
            const int gidx = ((lane >> 5) & 1) * 8 + ((lane >> 4) & 1) * 4 + ((lane >> 3) & 1) * 2 + ((lane >> 2) & 1);
#pragma unroll
            for (int u = 0; u < 4; ++u) { float q = pv[u][0]; q += __shfl_xor(q, 2); q += __shfl_xor(q, 1);
                if ((lane & 3) == 0) part[((rr + u) * 8 + wid) * 16 + gidx] = q; }
        }
        __syncthreads();
        for (int e = tid; e < 36 * 16; e += 512) { const int rr = e >> 4, g = e & 15; float s = 0.f;
#pragma unroll
            for (int w = 0; w < 8; ++w) s += part[(rr * 8 + w) * 16 + g];
            GATES[(size_t)(r0 + rr) * 16 + g] = s; }
        __syncthreads();
    }
}

__device__ __forceinline__ void phase_conv(const Params& p, LAS unsigned char* lds, int bid, int nb) {
    const int tid = threadIdx.x, lane = tid & 63, wid = tid >> 6;
    LAS float* scl = (LAS float*)lds;
    LAS float* ksp = (LAS float*)(lds + 1024);
    const bf16_t* PROJ = (const bf16_t*)(p.ws + OFF_PROJ);
    const float* GATES = (const float*)(p.ws + OFF_GATES);
    float* GA = (float*)(p.ws + OFF_GA); float* GP = (float*)(p.ws + OFF_GP); float* GB = (float*)(p.ws + OFF_GB);
    float* BL = (float*)(p.ws + OFF_BL); float* PX = (float*)(p.ws + OFF_PX); float* KSUM = (float*)(p.ws + OFF_KSUM);
    bf16_t* QK = (bf16_t*)(p.ws + OFF_QK); bf16_t* KHT = (bf16_t*)(p.ws + OFF_XM); bf16_t* VT = (bf16_t*)(p.ws + OFF_VT); bf16_t* R = (bf16_t*)(p.ws + OFF_R);
    const int nmine = nb == 256 ? (bid < 64 ? 3 : (bid < 192 ? 5 : 4)) : (576 + 512 - bid + nb - 1) / nb;
    for (int it = 0; it < nmine; ++it) {
        int t;
        if (nb == 256) { const int nconv = bid < 64 ? 3 : 2; t = it < nconv ? bid + 256 * it : 576 + (bid - 64) + 192 * (it - nconv); }
        else t = bid + nb * it;
        if (t < 576) {
            const int gc = t >> 2, h = t & 3, row0 = gc * 64; int pos0, slen;
            if (gc < 128) { pos0 = (gc & 31) * 64; slen = 2048; } else { pos0 = ((gc - 128) & 3) * 64; slen = 256; }
            if (wid < 2) { const int dir = wid, row = row0 + lane;
                const float gi = GATES[(size_t)row * 16 + dir * 4 + h] + p.b_ig[dir * 4 + h];
                const float gf = GATES[(size_t)row * 16 + 8 + dir * 4 + h] + p.b_fg[dir * 4 + h];
                const float lfv = fminf(gf, 0.f) - log1pf(__expf(-fabsf(gf)));
                float bc = lfv;
                if (dir == 0) {
#pragma unroll
                    for (int off = 1; off < 64; off <<= 1) { const float v = __shfl_up(bc, off); if (lane >= off) bc += v; }
                } else {
#pragma unroll
                    for (int off = 1; off < 64; off <<= 1) { const float v = __shfl_down(bc, off); if (lane + off < 64) bc += v; }
                }
                const float a = gi - bc; float pm = a;
                if (dir == 0) {
#pragma unroll
                    for (int off = 1; off < 64; off <<= 1) { const float v = __shfl_up(pm, off); if (lane >= off) pm = fmaxf(pm, v); }
                } else {
#pragma unroll
                    for (int off = 1; off < 64; off <<= 1) { const float v = __shfl_down(pm, off); if (lane + off < 64) pm = fmaxf(pm, v); }
                }
                const float bl = __shfl(bc, dir == 0 ? 63 : 0), px = __shfl(pm, dir == 0 ? 63 : 0);
                const size_t idx = (size_t)(dir * 4 + h) * 9216 + row; GA[idx] = a; GP[idx] = pm; GB[idx] = bc;
                if (lane == 0) { BL[(dir * 4 + h) * 144 + gc] = bl; PX[(dir * 4 + h) * 144 + gc] = px; }
                scl[dir * 64 + lane] = __expf(a - px);
            }
            {
                const int cg = tid & 63, rg = tid >> 6; const bool isk = cg >= 32; const int ch = (isk ? 1024 : 0) + h * 256 + (cg & 31) * 8;
                float w0[8], w1[8], w2[8];
#pragma unroll
                for (int hq = 0; hq < 2; ++hq) { const f32x4 a0 = *(const f32x4*)(p.conv_qk + ch + hq * 4), a1 = *(const f32x4*)(p.conv_qk + 2048 + ch + hq * 4), a2 = *(const f32x4*)(p.conv_qk + 4096 + ch + hq * 4);
#pragma unroll
                    for (int i = 0; i < 4; ++i) { w0[hq * 4 + i] = a0[i]; w1[hq * 4 + i] = a1[i]; w2[hq * 4 + i] = a2[i]; } }
                float prev[8], cur[8], nxt[8];
                const int s0 = rg * 8;
                u32x4 raw[10];
#pragma unroll
                for (int ii = 0; ii < 10; ++ii) { int sr = s0 - 1 + ii; const int pp = pos0 + sr; if (pp < 0) sr += 1; if (pp >= slen) sr -= 1;
                    raw[ii] = *(const u32x4*)(PROJ + (size_t)(row0 + sr) * 7168 + ch); }
                u32x4 vw[8];
#pragma unroll
                for (int ii = 0; ii < 8; ++ii) vw[ii] = *(const u32x4*)(PROJ + (size_t)(row0 + s0 + ii) * 7168 + 2048 + h * 256 + (cg & 31) * 8);
                if (pos0 + s0 - 1 < 0) raw[0] = (u32x4){0u, 0u, 0u, 0u};
                if (pos0 + s0 + 8 >= slen) raw[9] = (u32x4){0u, 0u, 0u, 0u};
                unpack8(raw[0], prev); unpack8(raw[1], cur);
                const float osc = isk ? 0.0625f : 1.f;
                float o[8][8];
#pragma unroll
                for (int ii = 0; ii < 8; ++ii) { const int s = s0 + ii;
                    unpack8(raw[ii + 2], nxt);
#pragma unroll
                    for (int i = 0; i < 8; ++i) { const float cv = w0[i] * prev[i] + w1[i] * cur[i] + w2[i] * nxt[i]; o[ii][i] = silu_f(cv) * osc; }
                    *(u32x4*)(QK + (size_t)(row0 + s) * 2048 + ch) = pack8(o[ii]);
#pragma unroll
                    for (int i = 0; i < 8; ++i) { prev[i] = cur[i]; cur[i] = nxt[i]; }
                }
                __syncthreads();
                if (isk) { const int kl = (cg & 31) * 8;
#pragma unroll
                    for (int dir = 0; dir < 2; ++dir) { float sc[8];
#pragma unroll
                        for (int ii = 0; ii < 8; ++ii) sc[ii] = scl[dir * 64 + s0 + ii];
                        bf16_t* dst = KHT + ((size_t)((dir * 144 + gc) * 4 + h) * 256 + kl) * 64 + s0;
#pragma unroll
                        for (int i = 0; i < 8; ++i) { u32x4 w; float ks = 0.f;
#pragma unroll
                            for (int j = 0; j < 4; ++j) { const float a = o[2 * j][i] * sc[2 * j], b2 = o[2 * j + 1][i] * sc[2 * j + 1]; w[j] = cvt_pk_bf16(a, b2); ks += a + b2; }
                            *(u32x4*)(dst + (size_t)i * 64) = w;
                            ksp[(rg * 2 + dir) * 256 + kl + i] = ks; } }
                } else { bf16_t* dst = VT + ((size_t)(gc * 4 + h) * 256 + cg * 8) * 64 + s0;
#pragma unroll
                    for (int i = 0; i < 8; ++i) { u32x4 w;
#pragma unroll
                        for (int j = 0; j < 4; ++j) { const unsigned a = vw[2 * j][i >> 1], b2 = vw[2 * j + 1][i >> 1]; w[j] = (i & 1) ? ((a >> 16) | (b2 & 0xffff0000u)) : ((a & 0xffffu) | (b2 << 16)); }
                        *(u32x4*)(dst + (size_t)i * 64) = w; } }
            }
            __syncthreads();
            { const int dir = tid >> 8, k = tid & 255; float sum = 0.f;
#pragma unroll
              for (int rg = 0; rg < 8; ++rg) sum += ksp[(rg * 2 + dir) * 256 + k];
              KSUM[(size_t)((dir * 144 + gc) * 4 + h) * 256 + k] = sum; }
            __syncthreads();
        } else {
            const int tr = t - 576, seg = tr >> 2, g = tr & 3; const int row0 = seg * 64;
            LAS bf16_t* ut = (LAS bf16_t*)lds;
#pragma unroll
            for (int i = 0; i < 4; ++i) { const int e = tid + 512 * i, r = e >> 5, c = e & 31;
                *(LAS u32x4*)(ut + r * 264 + c * 8) = *(const u32x4*)(PROJ + (size_t)(row0 + r) * 7168 + 5120 + g * 256 + c * 8); }
            __syncthreads();
            { const int c8 = tid & 31, w = 2 << g; const float invw = 1.f / (float)w;
#pragma unroll
              for (int k = 0; k < 4; ++k) { const int pos = (tid >> 5) + 16 * k; const int lo = max(pos - w / 2, 0), hi = min(pos + (w - 1 - w / 2), 63);
                  float sum[8];
#pragma unroll
                  for (int q = 0; q < 8; ++q) sum[q] = 0.f;
                  for (int rr = lo; rr <= hi; ++rr) { float f[8]; unpack8(*(const LAS u32x4*)(ut + rr * 264 + c8 * 8), f);
#pragma unroll
                      for (int q = 0; q < 8; ++q) sum[q] += f[q]; }
                  float u[8]; unpack8(*(const LAS u32x4*)(ut + pos * 264 + c8 * 8), u);
                  const float inv = (hi - lo + 1 == w) ? invw : 1.f / (float)(hi - lo + 1); float o[8];
#pragma unroll
                  for (int q = 0; q < 8; ++q) o[q] = sum[q] * inv - u[q];
                  *(u32x4*)(R + (size_t)(row0 + pos) * 1024 + g * 256 + c8 * 8) = pack8(o); } }
            __syncthreads();
        }
    }
}

__device__ __forceinline__ void phase_intra(const Params& p, LAS unsigned char* lds, int bid, int nb) {
    const int tid = threadIdx.x, lane = tid & 63, wid = tid >> 6, quad = lane >> 4, l15 = lane & 15;
    LAS bf16_t* Qs = (LAS bf16_t*)lds;
    LAS bf16_t* Ks = (LAS bf16_t*)(lds + 33792);
    LAS bf16_t* Vs = (LAS bf16_t*)(lds + 67584);
    LAS bf16_t* Ps = (LAS bf16_t*)(lds + 104448);
    LAS float* fs = (LAS float*)(lds + 113664);
    LAS float* a_s = fs; LAS float* pm_s = fs + 64; LAS float* bc_s = fs + 128; LAS float* nvec = fs + 192; LAS float* rsp = fs + 448; LAS float* coef_s = fs + 576; LAS float* qn_s = fs + 640; LAS float* bl_s = fs + 704; LAS float* px_s = fs + 768;
    const float* GA = (const float*)(p.ws + OFF_GA); const float* GP = (const float*)(p.ws + OFF_GP); const float* GB = (const float*)(p.ws + OFF_GB);
    const float* BL = (const float*)(p.ws + OFF_BL); const float* PX = (const float*)(p.ws + OFF_PX); const float* KSUM = (const float*)(p.ws + OFF_KSUM);
    float* GAM = (float*)(p.ws + OFF_GAM);
    const bf16_t* QK = (const bf16_t*)(p.ws + OFF_QK); const bf16_t* VT = (const bf16_t*)(p.ws + OFF_VT);
    for (int t = bid; t < 1024; t += nb) {
        const int dir = t >> 9, b = (t >> 7) & 3, h = (t >> 5) & 3, lc = t & 31;
        const int gc = b * 32 + lc, row0 = gc * 64, dh = dir * 4 + h;
        bf16_t* Hd = (bf16_t*)(p.ws + OFF_H) + (size_t)(dir * 2) * 8192 * 1024;
        float m = 0.f, nk = 0.f; const int k = tid & 255;
        const int nprev = dir == 0 ? 4 + lc : 4 + (31 - lc);
#define INTRA_G2(i_) ((i_) < 4 ? 128 + b * 4 + (dir == 0 ? (i_) : 3 - (i_)) : b * 32 + (dir == 0 ? (i_) - 4 : 35 - (i_)))
        if (tid < nprev) { const int g2 = INTRA_G2(tid); bl_s[tid] = BL[dh * 144 + g2]; px_s[tid] = PX[dh * 144 + g2]; }
        __syncthreads();
        { int i = 0;
          for (; i + 4 <= nprev; i += 4) { float ks[4];
#pragma unroll
              for (int u = 0; u < 4; ++u) { const int g2 = INTRA_G2(i + u); ks[u] = KSUM[(size_t)((dir * 144 + g2) * 4 + h) * 256 + k]; }
#pragma unroll
              for (int u = 0; u < 4; ++u) { const float px = px_s[i + u], mm = fmaxf(px, m); const float dec = __expf(m - mm), sig = __expf(px - mm); nk = dec * nk + sig * ks[u]; m = bl_s[i + u] + mm; } }
          for (; i < nprev; ++i) { const int g2 = INTRA_G2(i); const float ksv = KSUM[(size_t)((dir * 144 + g2) * 4 + h) * 256 + k];
              const float px = px_s[i], mm = fmaxf(px, m); const float dec = __expf(m - mm), sig = __expf(px - mm); nk = dec * nk + sig * ksv; m = bl_s[i] + mm; } }
#undef INTRA_G2
        if (tid < 256) nvec[tid] = nk;
        if (tid < 64) { a_s[tid] = GA[(size_t)dh * 9216 + row0 + tid]; pm_s[tid] = GP[(size_t)dh * 9216 + row0 + tid]; bc_s[tid] = GB[(size_t)dh * 9216 + row0 + tid]; }
#pragma unroll
        for (int i = 0; i < 4; ++i) { const int e = tid + 512 * i, r = e >> 5, c = e & 31;
            *(LAS u32x4*)(Qs + r * 264 + c * 8) = *(const u32x4*)(QK + (size_t)(row0 + r) * 2048 + h * 256 + c * 8);
            *(LAS u32x4*)(Ks + r * 264 + c * 8) = *(const u32x4*)(QK + (size_t)(row0 + r) * 2048 + 1024 + h * 256 + c * 8); }
#pragma unroll
        for (int i = 0; i < 4; ++i) { const int e = tid + 512 * i, r = e >> 3, c = e & 7;
            *(LAS u32x4*)(Vs + r * 72 + c * 8) = *(const u32x4*)(VT + ((size_t)(gc * 4 + h) * 256 + r) * 64 + c * 8); }
        __syncthreads();
        {
            const int tt = wid & 3, sp = wid >> 2; float rsum = 0.f; const int tcol = tt * 16 + l15; const float pmt = pm_s[tcol];
#pragma unroll
            for (int q = 0; q < 2; ++q) { const int st = sp * 2 + q; f32x4 acc = {0.f, 0.f, 0.f, 0.f};
#pragma unroll
                for (int ks = 0; ks < 8; ++ks) { const bf16x8 a = ldfrag(Ks, 264, st * 16 + l15, ks * 32 + quad * 8); const bf16x8 bq = ldfrag(Qs, 264, tt * 16 + l15, ks * 32 + quad * 8); acc = MFMA16(a, bq, acc); }
                float pv[4];
#pragma unroll
                for (int j = 0; j < 4; ++j) { const int s = st * 16 + quad * 4 + j; const bool valid = dir == 0 ? (s <= tcol) : (s >= tcol);
                    const float e = __expf(fminf(a_s[s] - pmt, 0.f)); pv[j] = valid ? acc[j] * e : 0.f; rsum += pv[j]; }
                u32x2 w; w[0] = cvt_pk_bf16(pv[0], pv[1]); w[1] = cvt_pk_bf16(pv[2], pv[3]);
                *(LAS u32x2*)(Ps + tcol * 72 + st * 16 + quad * 4) = w; }
            rsum += __shfl_xor(rsum, 16); rsum += __shfl_xor(rsum, 32);
            if (quad == 0) rsp[sp * 64 + tcol] = rsum;
        }
        {
            const int t2 = tid >> 3, j8 = tid & 7; float qn = 0.f;
#pragma unroll
            for (int kk = 0; kk < 32; kk += 8) { float f[8]; unpack8(*(const LAS u32x4*)(Qs + t2 * 264 + j8 * 32 + kk), f);
#pragma unroll
                for (int i = 0; i < 8; ++i) qn += f[i] * nvec[j8 * 32 + kk + i]; }
            qn += __shfl_xor(qn, 1); qn += __shfl_xor(qn, 2); qn += __shfl_xor(qn, 4);
            if (j8 == 0) qn_s[t2] = qn;
        }
        __syncthreads();
        if (tid < 64) { const float mm = fmaxf(pm_s[tid], m); const float rho = __expf(pm_s[tid] - mm), wi = __expf(m - mm), thr = __expf(-bc_s[tid] - mm);
            const float den = rho * (rsp[tid] + rsp[64 + tid]) + wi * qn_s[tid]; const float Dn = fmaxf(fabsf(den), thr);
            coef_s[tid] = rho / Dn; GAM[(size_t)dh * 8192 + row0 + tid] = wi / Dn; }
        __syncthreads();
        {
#pragma unroll
            for (int v2 = 0; v2 < 2; ++v2) { const int vt_ = wid * 2 + v2;
                const bf16x8 a0 = ldfrag(Vs, 72, vt_ * 16 + l15, quad * 8), a1 = ldfrag(Vs, 72, vt_ * 16 + l15, 32 + quad * 8);
#pragma unroll
                for (int tt = 0; tt < 4; ++tt) { f32x4 acc = {0.f, 0.f, 0.f, 0.f};
                    acc = MFMA16(a0, ldfrag(Ps, 72, tt * 16 + l15, quad * 8), acc); acc = MFMA16(a1, ldfrag(Ps, 72, tt * 16 + l15, 32 + quad * 8), acc);
                    const int tq = tt * 16 + l15; const float cf = coef_s[tq];
                    { const f32x4 o = acc * cf; u32x2 w; w[0] = cvt_pk_bf16(o[0], o[1]); w[1] = cvt_pk_bf16(o[2], o[3]);
                      *(u32x2*)(Hd + (size_t)(row0 + tq) * 1024 + h * 256 + vt_ * 16 + quad * 4) = w; } } }
        }
        __syncthreads();
    }
}

struct ScanS { u32x4 q[4]; u32x4 v; float g; };
struct ScanD { bf16x8 ka[2][2]; };
__device__ __forceinline__ void phase_scan(const Params& p, LAS unsigned char* lds, int bid, int nb, bool dry) {
    if (bid >= 256) return;
    const int tid = threadIdx.x, lane = tid & 63, wid = tid >> 6, quad = lane >> 4, l15 = lane & 15;
    int slot;
    { volatile LAS unsigned* bst = (volatile LAS unsigned*)(lds + 131072); const unsigned xcc = bst[2], r = bst[3]; unsigned ov = bst[4];
      if (gridDim.x != 256) slot = bid;
      else if (ov == 0u) slot = (int)(xcc * 32u + r);
      else { unsigned* bw = (unsigned*)(p.ws + OFF_BAR); ov -= 1u; slot = 0;
             for (unsigned x = 0; x < 8u; ++x) { unsigned c = __hip_atomic_load(&bw[3600 + x], __ATOMIC_RELAXED, __HIP_MEMORY_SCOPE_AGENT); c = c < 32u ? c : 32u; const unsigned fr = 32u - c; if (ov < fr) { slot = (int)(x * 32u + c + ov); break; } ov -= fr; } } }
    const int seq = slot >> 3, vs = slot & 7, dir = seq >> 4, b = (seq >> 2) & 3, h = seq & 3, dh = dir * 4 + h;
    constexpr int SET = 55552;
    LAS float* decs = (LAS float*)(lds + 2 * SET);
    LAS float* sigs = decs + 64; LAS float* pxs = decs + 128; LAS float* bls = decs + 192;
    const float* BL = (const float*)(p.ws + OFF_BL); const float* PX = (const float*)(p.ws + OFF_PX); const float* GAM = (const float*)(p.ws + OFF_GAM);
    const bf16_t* QK = (const bf16_t*)(p.ws + OFF_QK); const bf16_t* VT = (const bf16_t*)(p.ws + OFF_VT); const bf16_t* KHT = (const bf16_t*)(p.ws + OFF_XM);
    bf16_t* Hd = (bf16_t*)(p.ws + OFF_H) + (size_t)(dir * 2 + 1) * 8192 * 1024;
    const int tt = wid & 3, vt_ = wid >> 2, tq = tt * 16 + l15;
#define SCAN_GC(i_) const int jj = dir == 0 ? (i_) : ((i_) < 4 ? 3 - (i_) : 39 - (i_)); const bool lat = jj >= 4; const int gc = lat ? b * 32 + (jj - 4) : 128 + b * 4 + jj; const int row0 = gc * 64;
    if (tid < 36) { SCAN_GC(tid) (void)row0; pxs[tid] = PX[dh * 144 + gc]; bls[tid] = BL[dh * 144 + gc]; }
    __syncthreads();
    if (tid == 0) { float m = 0.f; for (int i = 0; i < 36; ++i) { const float px = pxs[i], mm = fmaxf(px, m); decs[i] = __expf(m - mm); sigs[i] = __expf(px - mm); m = bls[i] + mm; } }
    auto issueS = [&](ScanS& S, int i0) {
        const int i = i0 < 36 ? i0 : 35;
        SCAN_GC(i)
        const int rowc = lat ? row0 : b * 2048;
        S.v = *(const u32x4*)(VT + ((size_t)(gc * 4 + h) * 256 + vs * 32) * 64 + (tid & 255) * 8);
#pragma unroll
        for (int q = 0; q < 4; ++q) { const int e = tid + 512 * q, r = e >> 5, c = e & 31; S.q[q] = *(const u32x4*)(QK + (size_t)(rowc + r) * 2048 + h * 256 + c * 8); }
        S.g = 0.f;
    };
    auto stageS = [&](ScanS& S, int i) {
        LAS unsigned char* sb = lds + (i & 1) * SET;
        *(LAS u32x4*)((LAS bf16_t*)(sb + 33792) + ((tid & 255) >> 3) * 72 + (tid & 7) * 8) = S.v;
#pragma unroll
        for (int q = 0; q < 4; ++q) { const int e = tid + 512 * q; *(LAS u32x4*)((LAS bf16_t*)sb + (e >> 5) * 264 + (e & 31) * 8) = S.q[q]; }
    };
    auto issueD = [&](ScanD& D, int i0) {
        const int i = i0 < 36 ? i0 : 35;
        SCAN_GC(i)
        const int rowc = lat ? row0 : b * 2048;
        const bf16_t* ksrc = KHT + (size_t)((dir * 144 + gc) * 4 + h) * 256 * 64;
#pragma unroll
        for (int k2 = 0; k2 < 2; ++k2) { const bf16_t* rp = ksrc + (size_t)((wid * 2 + k2) * 16 + l15) * 64 + quad * 8; D.ka[k2][0] = *(const bf16x8*)rp; D.ka[k2][1] = *(const bf16x8*)(rp + 32); }
        (void)rowc;
    };
    f32x4 C[2][2];
#pragma unroll
    for (int a = 0; a < 2; ++a)
#pragma unroll
        for (int c = 0; c < 2; ++c) C[a][c] = (f32x4){0.f, 0.f, 0.f, 0.f};
    auto step = [&](ScanD& D, ScanS& So, int i) {
        SCAN_GC(i)
        const int rowc = lat ? row0 : b * 2048;
        const LAS unsigned char* rb = lds + (i & 1) * SET; LAS unsigned char* wb = lds + ((i + 1) & 1) * SET;
        const LAS bf16_t* Qs = (const LAS bf16_t*)rb; const LAS bf16_t* Vs = (const LAS bf16_t*)(rb + 33792); const LAS bf16_t* Cr = (const LAS bf16_t*)(rb + 38400);
        LAS bf16_t* Cw = (LAS bf16_t*)(wb + 38400);
        stageS(So, i + 1);
        issueS(So, i + 3);
        const float dec = decs[i], sig = sigs[i];
        const bf16x8 vb00 = ldfrag(Vs, 72, l15, quad * 8), vb01 = ldfrag(Vs, 72, l15, 32 + quad * 8), vb10 = ldfrag(Vs, 72, 16 + l15, quad * 8), vb11 = ldfrag(Vs, 72, 16 + l15, 32 + quad * 8);
        { f32x4 acc = {0.f, 0.f, 0.f, 0.f};
            bf16x8 ca[8], qb[8];
#pragma unroll
            for (int ks = 0; ks < 8; ++ks) { ca[ks] = ldfrag(Cr, 264, vt_ * 16 + l15, ks * 32 + quad * 8); qb[ks] = ldfrag(Qs, 264, tt * 16 + l15, ks * 32 + quad * 8); }
            const float g = !lat ? 0.f : 1.f;
#pragma unroll
            for (int ks = 0; ks < 8; ++ks) acc = MFMA16(ca[ks], qb[ks], acc);
            { const f32x4 o = acc * g; u32x2 w; w[0] = cvt_pk_bf16(o[0], o[1]); w[1] = cvt_pk_bf16(o[2], o[3]);
              *(u32x2*)(Hd + (size_t)(rowc + tq) * 1024 + h * 256 + vs * 32 + vt_ * 16 + quad * 4) = w; } }
#pragma unroll
        for (int v2 = 0; v2 < 2; ++v2) { const bf16x8 b0 = v2 ? vb10 : vb00, b1 = v2 ? vb11 : vb01;
#pragma unroll
            for (int k2 = 0; k2 < 2; ++k2) { f32x4 d = {0.f, 0.f, 0.f, 0.f};
                d = MFMA16(D.ka[k2][0], b0, d); d = MFMA16(D.ka[k2][1], b1, d);
                C[k2][v2] = C[k2][v2] * dec + d * sig;
                u32x2 w; w[0] = cvt_pk_bf16(C[k2][v2][0], C[k2][v2][1]); w[1] = cvt_pk_bf16(C[k2][v2][2], C[k2][v2][3]);
                *(LAS u32x2*)(Cw + (v2 * 16 + l15) * 264 + (wid * 2 + k2) * 16 + quad * 4) = w; } }
        issueD(D, i + 2);
        asm volatile("s_waitcnt lgkmcnt(0)\n\ts_barrier" ::: "memory");
    };
    for (int e = tid; e < 2 * SET / 16; e += 512) *(LAS u32x4*)(lds + e * 16) = (u32x4){0u, 0u, 0u, 0u};
    __syncthreads();
    ScanS Sa, Sb; ScanD D0, D1;
    issueS(Sa, 0); issueD(D0, 0); issueD(D1, 1); issueS(Sb, 1);
    stageS(Sa, 0); issueS(Sa, 2);
    __syncthreads();
    for (int i = 0; i < 36; i += 2) { step(D0, Sb, i); step(D1, Sa, i + 1); }
#undef SCAN_GC
}

__device__ __forceinline__ void phase_mout(const Params& p, int it_lo, int it_hi, int wave0, int nwaves) {
    const int lane = threadIdx.x & 63;
    const bf16_t* H4 = (const bf16_t*)(p.ws + OFF_H); constexpr size_t HPL = (size_t)8192 * 1024;
    const float* GAM = (const float*)(p.ws + OFF_GAM);
    const bf16_t* PROJ = (const bf16_t*)(p.ws + OFF_PROJ); bf16_t* Y = (bf16_t*)(p.ws + OFF_QK);
    for (int it0 = it_lo + wave0; it0 < it_hi; it0 += 4 * nwaves) {
        f32x4 hf[4], hb[4]; u32x2 ow[4], zw[4]; f32x4 gg[4]; float hv[4][4], s[4], v[4];
#pragma unroll
        for (int u = 0; u < 4; ++u) { int it = it0 + u * nwaves; if (it >= it_hi) it = it0; const int row = it >> 2, h = it & 3, c = h * 256 + lane * 4;
            { const u32x2 a0 = *(const u32x2*)(H4 + (size_t)row * 1024 + c), a1 = *(const u32x2*)(H4 + HPL + (size_t)row * 1024 + c), a2 = *(const u32x2*)(H4 + 2 * HPL + (size_t)row * 1024 + c), a3 = *(const u32x2*)(H4 + 3 * HPL + (size_t)row * 1024 + c);
              const float gf = GAM[(size_t)h * 8192 + row], gb = GAM[(size_t)(4 + h) * 8192 + row];
              hf[u] = (f32x4){bflo(a0[0]) + gf * bflo(a1[0]), bfhi(a0[0]) + gf * bfhi(a1[0]), bflo(a0[1]) + gf * bflo(a1[1]), bfhi(a0[1]) + gf * bfhi(a1[1])};
              hb[u] = (f32x4){bflo(a2[0]) + gb * bflo(a3[0]), bfhi(a2[0]) + gb * bfhi(a3[0]), bflo(a2[1]) + gb * bflo(a3[1]), bfhi(a2[1]) + gb * bfhi(a3[1])}; }
            ow[u] = *(const u32x2*)(PROJ + (size_t)row * 7168 + 3072 + c); zw[u] = *(const u32x2*)(PROJ + (size_t)row * 7168 + 4096 + c);
            gg[u] = *(const f32x4*)(p.mh_g + c); }
#pragma unroll
        for (int u = 0; u < 4; ++u) { const float o[4] = {bflo(ow[u][0]), bfhi(ow[u][0]), bflo(ow[u][1]), bfhi(ow[u][1])}; s[u] = 0.f;
#pragma unroll
            for (int i = 0; i < 4; ++i) { hv[u][i] = (hf[u][i] + hb[u][i]) * sigm_f(o[i]); s[u] += hv[u][i]; } }
#pragma unroll
        for (int u = 0; u < 4; ++u) s[u] = wave_sum(s[u]);
#pragma unroll
        for (int u = 0; u < 4; ++u) { const float mu = s[u] * (1.f / 256.f); v[u] = 0.f;
#pragma unroll
            for (int i = 0; i < 4; ++i) { hv[u][i] -= mu; v[u] += hv[u][i] * hv[u][i]; } }
#pragma unroll
        for (int u = 0; u < 4; ++u) v[u] = wave_sum(v[u]);
#pragma unroll
        for (int u = 0; u < 4; ++u) { const int it = it0 + u * nwaves; if (it < it_hi) { const int row = it >> 2, h = it & 3, c = h * 256 + lane * 4;
            const float rstd = rsqrtf(v[u] * (1.f / 256.f) + 1e-5f);
            const float z[4] = {bflo(zw[u][0]), bfhi(zw[u][0]), bflo(zw[u][1]), bfhi(zw[u][1])}; float y[4];
#pragma unroll
            for (int i = 0; i < 4; ++i) y[i] = hv[u][i] * rstd * gg[u][i] * silu_f(z[i]);
            u32x2 w; w[0] = cvt_pk_bf16(y[0], y[1]); w[1] = cvt_pk_bf16(y[2], y[3]);
            *(u32x2*)(Y + (size_t)row * 2048 + c) = w; } }
    }
}

__device__ __forceinline__ void phase_ln(const Params& p, int layer, bool domod, int wave0, int nwaves) {
    const int lane = threadIdx.x & 63;
    const float* mod1 = (const float*)(p.ws + OFF_MOD) + 5 * 6144;
    bf16_t* XM1 = (bf16_t*)(p.ws + OFF_XM);
    for (int row = wave0; row < 8192; row += nwaves) { float* rp = p.out + (size_t)row * 2048; const int b = row >> 11;
        f32x4 v[8]; float s = 0.f;
#pragma unroll
        for (int i = 0; i < 8; ++i) { v[i] = *(const f32x4*)(rp + (i * 64 + lane) * 4); s += v[i][0] + v[i][1] + v[i][2] + v[i][3]; }
#pragma unroll
        for (int off = 1; off < 64; off <<= 1) s += __shfl_xor(s, off);
        const float mu = s * (1.f / 2048.f); float q = 0.f;
#pragma unroll
        for (int i = 0; i < 8; ++i) { v[i] -= mu; q += v[i][0] * v[i][0] + v[i][1] * v[i][1] + v[i][2] * v[i][2] + v[i][3] * v[i][3]; }
#pragma unroll
        for (int off = 1; off < 64; off <<= 1) q += __shfl_xor(q, off);
        const float rstd = rsqrtf(q * (1.f / 2048.f) + 1e-5f);
#pragma unroll
        for (int i = 0; i < 8; ++i) { const int col = (i * 64 + lane) * 4;
            const f32x4 g = *(const f32x4*)(p.pln_g + layer * 2048 + col), bb = *(const f32x4*)(p.pln_b + layer * 2048 + col);
            const f32x4 y = v[i] * rstd * g + bb; *(f32x4*)(rp + col) = y;
            if (domod) { const f32x4 sh = *(const f32x4*)(mod1 + (size_t)b * 6144 + col), sc = *(const f32x4*)(mod1 + (size_t)b * 6144 + 2048 + col);
                const f32x4 xm = y * (sc + 1.f) + sh; u32x2 w; w[0] = cvt_pk_bf16(xm[0], xm[1]); w[1] = cvt_pk_bf16(xm[2], xm[3]);
                *(u32x2*)(XM1 + (size_t)row * 2048 + col) = w; } }
    }
}

__device__ __forceinline__ void phase_sguln(const Params& p, LAS unsigned char* lds, int bid, int nb) {
    const int tid = threadIdx.x, lane = tid & 63, wid = tid >> 6;
    LAS bf16_t* tile = (LAS bf16_t*)lds;
    const bf16_t* PROJ1 = (const bf16_t*)(p.ws + OFF_PROJ); bf16_t* VNT = (bf16_t*)(p.ws + OFF_H);
    for (int t = bid; t < 256; t += nb) { const int b = t >> 6, n = (t >> 2) & 15, rq = t & 3; const int row0 = b * 2048 + n * 128 + rq * 32;
        u32x4 raw[4][4];
#pragma unroll
        for (int rr = 0; rr < 4; ++rr)
#pragma unroll
            for (int i = 0; i < 4; ++i) raw[rr][i] = *(const u32x4*)(PROJ1 + (size_t)(row0 + wid * 4 + rr) * 6144 + 2048 + (i * 64 + lane) * 8);
        float mu[4], rs[4];
        { float s[4];
#pragma unroll
          for (int rr = 0; rr < 4; ++rr) { s[rr] = 0.f;
#pragma unroll
              for (int i = 0; i < 4; ++i) { float f[8]; unpack8(raw[rr][i], f);
#pragma unroll
                  for (int q = 0; q < 8; ++q) s[rr] += f[q]; } }
#pragma unroll
          for (int off = 1; off < 64; off <<= 1) {
#pragma unroll
              for (int rr = 0; rr < 4; ++rr) s[rr] += __shfl_xor(s[rr], off); }
          float v[4];
#pragma unroll
          for (int rr = 0; rr < 4; ++rr)
#pragma unroll
              for (int i = 0; i < 4; ++i) asm volatile("" : "+v"(raw[rr][i]));
#pragma unroll
          for (int rr = 0; rr < 4; ++rr) { mu[rr] = s[rr] * (1.f / 2048.f); v[rr] = 0.f;
#pragma unroll
              for (int i = 0; i < 4; ++i) { float f[8]; unpack8(raw[rr][i], f);
#pragma unroll
                  for (int q = 0; q < 8; ++q) { const float d = f[q] - mu[rr]; v[rr] += d * d; } } }
#pragma unroll
          for (int off = 1; off < 64; off <<= 1) {
#pragma unroll
              for (int rr = 0; rr < 4; ++rr) v[rr] += __shfl_xor(v[rr], off); }
#pragma unroll
          for (int rr = 0; rr < 4; ++rr) rs[rr] = rsqrtf(v[rr] * (1.f / 2048.f) + 1e-5f); }
#pragma unroll
        for (int rr = 0; rr < 4; ++rr)
#pragma unroll
            for (int i = 0; i < 4; ++i) asm volatile("" : "+v"(raw[rr][i]));
#pragma unroll
        for (int half = 0; half < 2; ++half) {
#pragma unroll
            for (int ii = 0; ii < 2; ++ii) { const int i = half * 2 + ii; const int col = (i * 64 + lane) * 8;
                const f32x4 g0 = *(const f32x4*)(p.sgu_g + col), g1 = *(const f32x4*)(p.sgu_g + col + 4), b0 = *(const f32x4*)(p.sgu_b + col), b1 = *(const f32x4*)(p.sgu_b + col + 4);
                float f[4][8];
#pragma unroll
                for (int rr = 0; rr < 4; ++rr) unpack8(raw[rr][i], f[rr]);
#pragma unroll
                for (int q = 0; q < 8; ++q) { const float gq = q < 4 ? g0[q & 3] : g1[q & 3], bq = q < 4 ? b0[q & 3] : b1[q & 3];
                    float y[4];
#pragma unroll
                    for (int rr = 0; rr < 4; ++rr) y[rr] = (f[rr][q] - mu[rr]) * rs[rr] * gq + bq;
                    u32x2 w; w[0] = cvt_pk_bf16(y[0], y[1]); w[1] = cvt_pk_bf16(y[2], y[3]);
                    *(LAS u32x2*)(tile + (q * 128 + ii * 64 + lane) * 36 + wid * 4) = w; } }
            __syncthreads();
#pragma unroll
            for (int k = 0; k < 2; ++k) { const int prow = tid + 512 * k; const int c = ((prow & 127) << 3) | (prow >> 7);
                bf16_t* dst = VNT + ((size_t)((b * 16 + n) * 2048 + half * 1024 + c)) * 128 + rq * 32;
#pragma unroll
                for (int q = 0; q < 4; ++q) { const u32x2 lo = *(const LAS u32x2*)(tile + prow * 36 + q * 8), hi = *(const LAS u32x2*)(tile + prow * 36 + q * 8 + 4);
                    u32x4 w; w[0] = lo[0]; w[1] = lo[1]; w[2] = hi[0]; w[3] = hi[1]; *(u32x4*)(dst + q * 8) = w; } }
            __syncthreads();
        }
    }
}

__device__ __forceinline__ void phase_sgu(const Params& p, LAS unsigned char* lds, int bid, int nb) {
    const int tid = threadIdx.x, lane = tid & 63, wid = tid >> 6, quad = lane >> 4, l15 = lane & 15;
    LAS bf16_t* Xs = (LAS bf16_t*)lds;
    LAS bf16_t* Ws = (LAS bf16_t*)(lds + 78336);
    LAS float* st = (LAS float*)(lds + 113152);
    const bf16_t* PROJ1 = (const bf16_t*)(p.ws + OFF_PROJ); const bf16_t* WSP = (const bf16_t*)(p.ws + OFF_WSP); const float* RS2 = (const float*)(p.ws + OFF_RS2);
    bf16_t* Y1 = (bf16_t*)(p.ws + OFF_QK);
    int hloaded = -1;
    const int xrow0 = (l15 & 3) * 36 + 4 * wid + (l15 >> 2);
    for (int t = bid; t < 512; t += nb) { const int h = t & 7, n = (t >> 3) & 15, b = t >> 7; const size_t crow = (size_t)b * 2048 + n * 128;
        if (tid < 128) { const float* src = RS2 + (crow + tid) * 64; float sm = 0.f, sq = 0.f;
#pragma unroll
            for (int j = 0; j < 16; ++j) { const f32x4 v4 = *(const f32x4*)(src + 4 * j); sm += v4[0] + v4[2]; sq += v4[1] + v4[3]; }
            const float mu = sm * (1.f / 2048.f); const float var = fmaxf(sq * (1.f / 2048.f) - mu * mu, 0.f);
            st[tid * 2] = mu; st[tid * 2 + 1] = rsqrtf(var + 1e-5f); }
        if (h != hloaded) { hloaded = h;
#pragma unroll 1
            for (int i = 0; i < 4; ++i) { const int e = tid + 512 * i, r = e >> 4, c = e & 15; *(LAS u32x4*)(Ws + r * 136 + c * 8) = *(const u32x4*)(WSP + (size_t)h * 16384 + r * 128 + c * 8); } }
        const int c8 = tid & 31;
        u32x4 va[4], vb[4];
#pragma unroll
        for (int i = 0; i < 4; ++i) { const int sp = (tid >> 5) + 16 * i; const bf16_t* vp = PROJ1 + (size_t)8192 * 2048 + (crow + 2 * sp) * 2048 + h * 256 + c8 * 8; va[i] = *(const u32x4*)vp; vb[i] = *(const u32x4*)(vp + 2048); }
        float gg[8], bb[8];
        { const f32x4 g0 = *(const f32x4*)(p.sgu_g + h * 256 + c8 * 8), g1 = *(const f32x4*)(p.sgu_g + h * 256 + c8 * 8 + 4), b0 = *(const f32x4*)(p.sgu_b + h * 256 + c8 * 8), b1 = *(const f32x4*)(p.sgu_b + h * 256 + c8 * 8 + 4);
#pragma unroll
          for (int q = 0; q < 4; ++q) { gg[q] = g0[q]; gg[4 + q] = g1[q]; bb[q] = b0[q]; bb[4 + q] = b1[q]; } }
        __syncthreads();
#pragma unroll
        for (int i = 0; i < 4; ++i) { const int sp = (tid >> 5) + 16 * i; float fa[8], fb[8]; unpack8(va[i], fa); unpack8(vb[i], fb);
            const float mua = st[4 * sp], rsa = st[4 * sp + 1], mub = st[4 * sp + 2], rsb = st[4 * sp + 3];
#pragma unroll
            for (int q = 0; q < 8; ++q) { const float ya = (fa[q] - mua) * rsa * gg[q] + bb[q], yb = (fb[q] - mub) * rsb * gg[q] + bb[q];
                *(LAS unsigned*)(Xs + (q * 36 + c8) * 136 + 2 * sp) = cvt_pk_bf16(ya, yb); } }
        __syncthreads();
#pragma unroll 1
        for (int th = 0; th < 2; ++th) {
            f32x4 acc[2][4];
#pragma unroll
            for (int a = 0; a < 2; ++a)
#pragma unroll
                for (int c = 0; c < 4; ++c) acc[a][c] = (f32x4){0.f, 0.f, 0.f, 0.f};
#pragma unroll
            for (int ks = 0; ks < 4; ++ks) { const bf16x8 a0 = ldfrag(Xs, 136, xrow0, ks * 32 + quad * 8), a1 = ldfrag(Xs, 136, xrow0 + 4 * 36, ks * 32 + quad * 8);
#pragma unroll
                for (int tt = 0; tt < 4; ++tt) { const bf16x8 bw = ldfrag(Ws, 136, (th * 4 + tt) * 16 + l15, ks * 32 + quad * 8); acc[0][tt] = MFMA16(a0, bw, acc[0][tt]); acc[1][tt] = MFMA16(a1, bw, acc[1][tt]); } }
#pragma unroll
            for (int tt = 0; tt < 4; ++tt) { const int tq = (th * 4 + tt) * 16 + l15; const size_t row = crow + tq; const int c0 = h * 256 + wid * 32 + quad * 8;
                const float bias = p.b_sp[h * 128 + tq];
                float gz[8], y[8]; unpack8(*(const u32x4*)(PROJ1 + row * 2048 + c0), gz);
#pragma unroll
                for (int q = 0; q < 4; ++q) { y[q] = gz[q] * (acc[0][tt][q] + bias); y[4 + q] = gz[4 + q] * (acc[1][tt][q] + bias); }
                *(u32x4*)(Y1 + row * 2048 + c0) = pack8(y); }
        }
        __syncthreads();
    }
}

#ifndef PHASE_MASK
#define PHASE_MASK 0xFFFF
#endif
#define PH_ON(n) (((PHASE_MASK) >> (n)) & 1)
typedef const __attribute__((address_space(4))) Params* cparams_t;
__device__ __forceinline__ Params ld_params() {
#if defined(__HIP_DEVICE_COMPILE__)
    cparams_t kp = (cparams_t)__builtin_amdgcn_kernarg_segment_ptr();
    asm volatile("" : "+s"(kp));
    Params r;
    typedef const __attribute__((address_space(1))) float* gptr_t;
    const __attribute__((address_space(4))) gptr_t* sp = (const __attribute__((address_space(4))) gptr_t*)kp;
    const float** fp = (const float**)&r;
#pragma unroll
    for (int i = 0; i < (int)(sizeof(Params) / 8); ++i) fp[i] = (const float*)sp[i];
    return r;
#else
    return Params{};
#endif
}
__global__ void __launch_bounds__(512, 2) fwd_megakernel(Params p_first_arg, int ph_lo, int ph_hi, int coop) {
    extern __shared__ __attribute__((aligned(16))) unsigned char shm[];
    LAS unsigned char* lds = (LAS unsigned char*)shm;
    cg::grid_group grid = cg::this_grid();
    const int bid = blockIdx.x, nb = gridDim.x;
    volatile LAS unsigned* bst = (volatile LAS unsigned*)(lds + 131072);
    if (threadIdx.x < 2) bst[threadIdx.x] = 0u;
    __syncthreads();
    const XcdBarrier xbar = xcd_barrier_post((unsigned*)(ld_params().ws + OFF_BAR), bst);
    if (threadIdx.x == 0) {
        unsigned* bw = (unsigned*)(ld_params().ws + OFF_BAR);
        const unsigned xcc = xb_xcc_id(); const unsigned r = xb_add(&bw[3600 + xcc], 1u);
        unsigned ov = 0u; if (xcc >= 8u || r >= 32u) ov = xb_add(&bw[3620], 1u) + 1u;
        bst[2] = xcc; bst[3] = r; bst[4] = ov; }
#define GRID_SYNC() do { if (coop == 2) grid.sync(); else xcd_barrier(xbar); } while (0)
    const int gw = bid * 8 + (threadIdx.x >> 6), nw = nb * 8;
#ifndef REP_MASK
#define REP_MASK 0ull
#endif
#ifndef EXTRA_SYNCS
#define EXTRA_SYNCS 0
#endif
#define PH_REPS(n) (1 + (int)(((REP_MASK) >> (4 * (n))) & 15ull))
#define PH_BEGIN(n) if (PH_ON(n) && ph_lo <= (n) && (n) < ph_hi) for (int rep_ = 0; rep_ < PH_REPS(n); ++rep_) { const bool dry = rep_ > 0; (void)dry; if (rep_ > 0 && coop) GRID_SYNC(); const Params p = ld_params();
#define PH_END(n) } if (coop && ph_lo <= (n) && (n) + 1 < ph_hi) GRID_SYNC();
        PH_BEGIN(0) phase_prep(p, lds, bid, nb); PH_END(0)
        PH_BEGIN(1) phase_mod0(p, lds, bid, nb); PH_END(1)
        PH_BEGIN(2) { pg8::Gemm g{(const bf16_t*)(p.ws + OFF_XM), (const bf16_t*)(p.ws + OFF_WINE), 2048, 2048, 2048, 0, PG8_ALIGN};
                  pg8::Sched S{1, 32, 28, 896, nb, bid}; pg8::Epi E{}; E.mode = 0; E.O = (bf16_t*)(p.ws + OFF_PROJ); E.ldc = 7168;
                  pg8::gemm_phase(lds, g, S, E);
                  { const int first = nb == 256 ? 160 : 0, nconv = nb - first;
                    if (bid >= first) { __syncthreads(); tr_loop(p, lds, 1, bid - first, 1024, nconv); } } } PH_END(2)
        PH_BEGIN(3) phase_conv(p, lds, bid, nb); PH_END(3)
        PH_BEGIN(4) phase_scan(p, lds, bid, nb, dry); __syncthreads(); phase_intra(p, lds, bid, nb); PH_END(4)
        PH_BEGIN(6) if (bid < 128) { pg8::Gemm g{(const bf16_t*)(p.ws + OFF_R), (const bf16_t*)(p.ws + OFF_POOLW), 1024, 256, 256, 256, 0};
                  pg8::Sched S{2, 32, 4, 128, 128, bid}; pg8::Epi E{}; E.mode = 1; E.O = (bf16_t*)(p.ws + OFF_QK); E.ldc = 2048; E.zsrc = (const bf16_t*)(p.ws + OFF_PROJ); E.pscale = p.pool_scale;
                  pg8::gemm_phase(lds, g, S, E); }
                else phase_mout(p, 0, 32768, (bid - 128) * 8 + (threadIdx.x >> 6), (nb - 128) * 8);
                PH_END(6)
        PH_BEGIN(7) { pg8::Gemm g{(const bf16_t*)(p.ws + OFF_QK), (const bf16_t*)(p.ws + OFF_WOUTE), 2048, 2048, 2048, 0, 0};
                  pg8::Sched S{0, 32, 8, 256, nb, bid}; pg8::Epi E{}; E.mode = 2; E.xres = p.x; E.gate = (const float*)(p.ws + OFF_MOD); E.out = p.out;
                  E.lng = p.pln_g; E.lnb = p.pln_b; E.mod1 = (const float*)(p.ws + OFF_MOD) + 5 * 6144; E.xm1 = (bf16_t*)(p.ws + OFF_XM); E.rstat = (float*)(p.ws + OFF_RSTAT); E.xb = &xbar;
                  pg8::gemm_phase(lds, g, S, E); } PH_END(7)
        PH_BEGIN(9) { pg8::Gemm g{(const bf16_t*)(p.ws + OFF_XM), (const bf16_t*)(p.ws + OFF_WINO), 2048, 2048, 2048, 0, PG8_ALIGN};
                  pg8::Sched S{0, 32, 24, 768, nb, bid}; pg8::Epi E{}; E.mode = 3; E.O = (bf16_t*)(p.ws + OFF_PROJ); E.O2 = (bf16_t*)(p.ws + OFF_PROJ) + (size_t)8192 * 2048; E.ldc = 2048; E.rs2 = (float*)(p.ws + OFF_RS2);
                  pg8::gemm_phase(lds, g, S, E); } PH_END(9)
        PH_BEGIN(11) phase_sgu(p, lds, bid, nb); PH_END(11)
        PH_BEGIN(12) { pg8::Gemm g{(const bf16_t*)(p.ws + OFF_QK), (const bf16_t*)(p.ws + OFF_WOUTO), 2048, 2048, 2048, 0, 0};
                  pg8::Sched S{0, 32, 8, 256, nb, bid}; pg8::Epi E{}; E.mode = 2; E.xres = p.out; E.gate = (const float*)(p.ws + OFF_MOD) + 5 * 6144; E.out = p.out;
                  E.lng = p.pln_g + 2048; E.lnb = p.pln_b + 2048; E.mod1 = nullptr; E.xm1 = nullptr; E.rstat = (float*)(p.ws + OFF_RSTAT); E.xb = &xbar;
                  pg8::gemm_phase(lds, g, S, E); } PH_END(12)
        if (coop) for (int es_ = 0; es_ < EXTRA_SYNCS; ++es_) GRID_SYNC();
}

#ifndef MK_SPLIT
#define MK_SPLIT 0
#endif
extern "C" void kernel_launch(void* const* d_in, const int* in_sizes, int n_in, void* d_out, int out_size, void* d_ws, size_t ws_size, hipStream_t stream) {
    constexpr int LDS_BYTES = 131072 + 256;
    static int grid = 0;
    if (grid == 0) {
        if (n_in != 22 || out_size != 8192 * 2048 || ws_size < WS_END) { fprintf(stderr, "kernel_launch: unexpected shapes (n_in %d out %d ws %zu need %zu)\n", n_in, out_size, ws_size, (size_t)WS_END); grid = -1; return; }
        int dev = 0, cus = 0, per_cu = 0;
        hipGetDevice(&dev); hipDeviceGetAttribute(&cus, hipDeviceAttributeMultiprocessorCount, dev);
        if (hipFuncSetAttribute((const void*)fwd_megakernel, hipFuncAttributeMaxDynamicSharedMemorySize, LDS_BYTES) != hipSuccess) { fprintf(stderr, "kernel_launch: hipFuncSetAttribute failed\n"); grid = -1; return; }
        hipOccupancyMaxActiveBlocksPerMultiprocessor(&per_cu, (const void*)fwd_megakernel, 512, LDS_BYTES);
        (void)hipGetLastError();
        if (per_cu < 1) per_cu = 1;
        grid = cus;
        if (grid < 256) fprintf(stderr, "kernel_launch: only %d CUs; this kernel wants 256\n", grid);
        if (grid > 256) grid = 256;
    }
    if (grid < 0) return;
    Params p{};
    const float** pp = (const float**)&p;
    for (int i = 0; i < 22; ++i) pp[i] = (const float*)d_in[i];
    p.out = (float*)d_out; p.ws = (unsigned char*)d_ws;
    if (hipMemsetAsync((char*)d_ws + OFF_BAR, 0, 16384, stream) != hipSuccess) { fprintf(stderr, "kernel_launch: memset of barrier words failed\n"); return; }
#if MK_SPLIT
    for (int ph = 0; ph < 13; ++ph) { int lo = ph, hi = ph + 1, coop = 0; hipLaunchKernelGGL(fwd_megakernel, dim3(grid), dim3(512), LDS_BYTES, stream, p, lo, hi, coop); }
#else
    int lo = 0, hi = 13, coop = 1;
    void* args[] = {&p, &lo, &hi, &coop};
    hipError_t e = hipLaunchCooperativeKernel((const void*)fwd_megakernel, dim3(grid), dim3(512), args, LDS_BYTES, stream);
    if (e != hipSuccess) fprintf(stderr, "cooperative launch failed: %s (grid %d)\n", hipGetErrorString(e), grid);
#endif
}
```

```cpp
#include <hip/hip_runtime.h>
#include <hip/hip_cooperative_groups.h>
#include <cstdio>
#include <cstdint>
namespace cg = cooperative_groups;

#define LAS __attribute__((address_space(3)))
typedef unsigned short bf16_t;
typedef short bf16x8 __attribute__((ext_vector_type(8)));
typedef float f32x4 __attribute__((ext_vector_type(4)));
typedef unsigned u32x4 __attribute__((ext_vector_type(4)));
typedef unsigned u32x2 __attribute__((ext_vector_type(2)));

constexpr size_t OFF_MODP  = 0;
constexpr size_t OFF_MOD   = OFF_MODP + 8ull * 2 * 5 * 6144 * 4;
constexpr size_t OFF_GATES = OFF_MOD + 2ull * 5 * 6144 * 4;
constexpr size_t OFF_GA    = OFF_GATES + 9216ull * 16 * 4;
constexpr size_t OFF_GP    = OFF_GA + 8ull * 9216 * 4;
constexpr size_t OFF_GB    = OFF_GP + 8ull * 9216 * 4;
constexpr size_t OFF_BL    = OFF_GB + 8ull * 9216 * 4;
constexpr size_t OFF_PX    = OFF_BL + 8ull * 144 * 4 + 512;
constexpr size_t OFF_KSUM  = OFF_PX + 8ull * 144 * 4 + 512;
constexpr size_t OFF_GAM   = OFF_KSUM + 2ull * 144 * 4 * 256 * 4;
constexpr size_t OFF_WINE  = (OFF_GAM + 8ull * 8192 * 4 + 4095) & ~4095ull;
constexpr size_t OFF_WOUTE = OFF_WINE + 7168ull * 2048 * 2;
constexpr size_t OFF_WINO  = OFF_WOUTE + 2048ull * 2048 * 2;
constexpr size_t OFF_WOUTO = OFF_WINO + 6144ull * 2048 * 2;
constexpr size_t OFF_POOLW = OFF_WOUTO + 2048ull * 2048 * 2;
constexpr size_t OFF_WSP   = OFF_POOLW + 4ull * 256 * 256 * 2;
constexpr size_t OFF_XM    = OFF_WSP + 8ull * 128 * 128 * 2;
constexpr size_t OFF_PROJ  = OFF_XM + 9216ull * 2048 * 2;
constexpr size_t OFF_QK    = OFF_PROJ + 9216ull * 7168 * 2;
constexpr size_t OFF_H     = OFF_QK + 9216ull * 2048 * 2;
constexpr size_t OFF_VT    = OFF_H + 2ull * 8192 * 1024 * 4;
constexpr size_t OFF_R     = OFF_VT + 144ull * 4 * 256 * 64 * 2;
constexpr size_t OFF_BAR   = OFF_R + 8192ull * 1024 * 2;
constexpr size_t OFF_RSTAT = OFF_BAR + 16384;
constexpr size_t OFF_RS2   = OFF_RSTAT + 8192ull * 16 * 4;
constexpr size_t WS_END    = OFF_RS2 + 8192ull * 64 * 4;

struct Params {
    const float *x, *c, *ctx, *cctx, *ada_w, *ada_b, *pln_g, *pln_b, *w_in_even, *conv_qk, *b_ig, *b_fg, *mh_g, *pool_w, *pool_scale,
        *w_out_even, *w_in_odd, *sgu_g, *sgu_b, *w_sp, *b_sp, *w_out_odd;
    float* out; unsigned char* ws;
};

__device__ __forceinline__ unsigned cvt_pk_bf16(float lo, float hi) { unsigned r; asm volatile("v_cvt_pk_bf16_f32 %0, %1, %2" : "=v"(r) : "v"(lo), "v"(hi)); return r; }
__device__ __forceinline__ float bflo(unsigned w) { return __uint_as_float(w << 16); }
__device__ __forceinline__ float bfhi(unsigned w) { return __uint_as_float(w & 0xffff0000u); }
__device__ __forceinline__ float bf1(bf16_t v) { return __uint_as_float(((unsigned)v) << 16); }
__device__ __forceinline__ bf16_t f2bf(float f) { unsigned u = __float_as_uint(f); return (bf16_t)((u + 0x7fffu + ((u >> 16) & 1u)) >> 16); }
__device__ __forceinline__ float silu_f(float x) { return x * __builtin_amdgcn_rcpf(1.f + __expf(-x)); }
__device__ __forceinline__ float sigm_f(float x) { return __builtin_amdgcn_rcpf(1.f + __expf(-x)); }
__device__ __forceinline__ void unpack8(const u32x4 w, float* f) { f[0] = bflo(w[0]); f[1] = bfhi(w[0]); f[2] = bflo(w[1]); f[3] = bfhi(w[1]); f[4] = bflo(w[2]); f[5] = bfhi(w[2]); f[6] = bflo(w[3]); f[7] = bfhi(w[3]); }
__device__ __forceinline__ u32x4 pack8(const float* f) { u32x4 w; w[0] = cvt_pk_bf16(f[0], f[1]); w[1] = cvt_pk_bf16(f[2], f[3]); w[2] = cvt_pk_bf16(f[4], f[5]); w[3] = cvt_pk_bf16(f[6], f[7]); return w; }
__device__ __forceinline__ bf16x8 ldfrag(const LAS bf16_t* base, int stride, int row, int kc) { return *(const LAS bf16x8*)(base + row * stride + kc); }
#define MFMA16(a, b, c) __builtin_amdgcn_mfma_f32_16x16x32_bf16(a, b, c, 0, 0, 0)
template <int CTRL> __device__ __forceinline__ float dpp_mov(float x) { return __builtin_bit_cast(float, __builtin_amdgcn_update_dpp(0, __builtin_bit_cast(int, x), CTRL, 0xf, 0xf, false)); }
__device__ __forceinline__ float rows_sum(float x) {
    { auto r = __builtin_amdgcn_permlane16_swap(__builtin_bit_cast(unsigned, x), __builtin_bit_cast(unsigned, x), false, false); x = __builtin_bit_cast(float, (unsigned)r[0]) + __builtin_bit_cast(float, (unsigned)r[1]); }
    { auto r = __builtin_amdgcn_permlane32_swap(__builtin_bit_cast(unsigned, x), __builtin_bit_cast(unsigned, x), false, false); x = __builtin_bit_cast(float, (unsigned)r[0]) + __builtin_bit_cast(float, (unsigned)r[1]); }
    return x;
}
__device__ __forceinline__ float wave_sum(float x) {
    x += dpp_mov<0xB1>(x);
    x += dpp_mov<0x4E>(x);
    x += dpp_mov<0x141>(x);
    x += dpp_mov<0x140>(x);
    const int xi = __builtin_bit_cast(int, x);
    const float r0 = __builtin_bit_cast(float, __builtin_amdgcn_readlane(xi, 0)), r1 = __builtin_bit_cast(float, __builtin_amdgcn_readlane(xi, 16));
    const float r2 = __builtin_bit_cast(float, __builtin_amdgcn_readlane(xi, 32)), r3 = __builtin_bit_cast(float, __builtin_amdgcn_readlane(xi, 48));
    return (r0 + r1) + (r2 + r3);
}

#define XB_TMO      128
#define XB_XCNT(j)  (256  + 64 * (j))
#define XB_XSUB(j)  (1280 + 64 * (j))
#define XB_XGEN(j)  (2304 + 64 * (j))
#define XB_TOP      3328
#define XB_TOPGEN   3392
#define XCD_BAR_WORDS 3456
#define XB_SPIN_CAP (1u << 18)
__device__ __forceinline__ unsigned xb_ld(unsigned* p)              { return __hip_atomic_load(p, __ATOMIC_RELAXED, __HIP_MEMORY_SCOPE_AGENT); }
__device__ __forceinline__ unsigned xb_add(unsigned* p, unsigned v) { return __hip_atomic_fetch_add(p, v, __ATOMIC_RELAXED, __HIP_MEMORY_SCOPE_AGENT); }
__device__ __forceinline__ unsigned xb_xcc_id() { return (unsigned)__builtin_amdgcn_s_getreg((3 << 11) | 20) & 0xFu; }
#define XB_SPIN(cond, bar) do { unsigned _sp = 0; while (cond) { __builtin_amdgcn_s_sleep(1); \
    if ((++_sp & 255u) == 0u) { if (xb_ld(&(bar)[XB_TMO])) break; if (_sp > XB_SPIN_CAP) { atomicAdd(&(bar)[XB_TMO], 1u); break; } } } } while (0)

struct XcdBarrier {
    unsigned* bar; unsigned x;
    volatile LAS unsigned* st;
};

__device__ __forceinline__ XcdBarrier xcd_barrier_post(unsigned* bar, volatile LAS unsigned* st) {
    XcdBarrier b; b.bar = bar; b.x = xb_xcc_id(); b.st = st;
    if (threadIdx.x == 0) (void)xb_add(&bar[XB_XCNT(b.x)], 1u);
    return b;
}
__device__ __forceinline__ void xcd_barrier_complete(unsigned* bar, unsigned x, unsigned& nloc, unsigned& nx) {
    const unsigned G = gridDim.x * gridDim.y * gridDim.z;
    unsigned sum, cnt, mine, sp = 0u;
    for (;;) {
        sum = 0u; cnt = 0u; mine = 0u;
#pragma unroll
        for (unsigned j = 0; j < 16; ++j) { const unsigned c = xb_ld(&bar[XB_XCNT(j)]); sum += c; cnt += (c > 0u) ? 1u : 0u; mine = (j == x) ? c : mine; }
        if (sum == G) break;
        __builtin_amdgcn_s_sleep(1);
        if ((++sp & 255u) == 0u) { if (xb_ld(&bar[XB_TMO])) break; if (sp > XB_SPIN_CAP) { atomicAdd(&bar[XB_TMO], 1u); break; } }
    }
    nloc = mine > 0u ? mine : 1u; nx = cnt > 0u ? cnt : 1u;
}

__device__ __forceinline__ void xcd_barrier(const XcdBarrier& b) {
    asm volatile("s_waitcnt vmcnt(0)" ::: "memory");
    __syncthreads();
    if (threadIdx.x == 0) {
        unsigned* bar = b.bar;
        __builtin_amdgcn_s_waitcnt(0);
        unsigned nloc = b.st[0], nx = b.st[1];
        if (nloc == 0u) { xcd_barrier_complete(bar, b.x, nloc, nx); b.st[0] = nloc; b.st[1] = nx; }
        const unsigned old = xb_add(&bar[XB_XSUB(b.x)], 1u);
        const unsigned gen = old / nloc;
        if (old + 1u == (gen + 1u) * nloc) {
            __builtin_amdgcn_fence(__ATOMIC_RELEASE, "agent");
            asm volatile("s_waitcnt vmcnt(0)" ::: "memory");
            const unsigned og = xb_add(&bar[XB_TOP], 1u);
            const unsigned tg = og / nx;
            if (og + 1u == (tg + 1u) * nx) xb_add(&bar[XB_TOPGEN], 1u);
            else XB_SPIN(xb_ld(&bar[XB_TOPGEN]) == tg, bar);
            __builtin_amdgcn_fence(__ATOMIC_ACQUIRE, "agent");
            xb_add(&bar[XB_XGEN(b.x)], 1u);
            asm volatile("s_waitcnt vmcnt(0)" ::: "memory");
        } else {
            XB_SPIN(xb_ld(&bar[XB_XGEN(b.x)]) == gen, bar);
            __builtin_amdgcn_fence(__ATOMIC_ACQUIRE, "agent");
            asm volatile("s_waitcnt vmcnt(0)" ::: "memory");
        }
    }
    __syncthreads();
}

#ifndef PG8_SP2
#define PG8_SP2 1
#endif
#ifndef PG8_ALIGN
#define PG8_ALIGN 1
#endif
namespace pg8 {
constexpr int BM = 256, BK = 64, HALF = 128, HTB = HALF * BK * 2, STAGE_BYTES = 8 * HTB, NXCD = 8, WGM = 8;
__device__ __forceinline__ int lds_byte(int r, int c) { const int st = (r >> 4) * 2 + (c >> 5), rr = r & 15, cc = c & 31, ob = rr * 64 + cc * 2; return st * 1024 + (ob ^ (((ob >> 9) & 1) << 5)); }
__device__ __forceinline__ void stage_rc(int b, int& R, int& C) { const int st = b / 1024, sb = b % 1024, swz = sb ^ (((sb >> 9) & 1) << 5); R = (st >> 1) * 16 + swz / 64; C = (st & 1) * 32 + (swz % 64) / 2; }
__device__ __forceinline__ int perm32(int rho) { const int n = rho >> 4, i = rho & 15; return 8 * (i >> 2) + 4 * n + (i & 3); }
struct Unit { int pm, pn; };
struct Gemm { const bf16_t* A; const bf16_t* Bt; int lda, ldb, K, acol; int align; };
struct Sched {
    int mode, nM, nN, nwg, G, c;
    __device__ __forceinline__ bool next(int i, Unit& u) const {
        const int L = i * G + c;
        if (mode == 2) { if (L >= 128) return false; u.pm = L & 31; u.pn = L >> 5; return true; }
        if (L >= nwg + (mode == 1 ? 32 : 0)) return false;
        if (L >= nwg) { const int e = L - nwg; u.pm = 32 + (e & 3); u.pn = 4 + (e >> 2); return true; }
        int wgid = L; { const int q = nwg / NXCD, r = nwg % NXCD, xcd = wgid % NXCD, off = wgid / NXCD; wgid = (xcd < r ? xcd * (q + 1) : r * (q + 1) + (xcd - r) * q) + off; }
        const int nig = WGM * nN, gid = wgid / nig, fm = gid * WGM, gsz = (nM - fm) < WGM ? (nM - fm) : WGM;
        u.pm = fm + ((wgid % nig) % gsz); u.pn = (wgid % nig) / gsz; return true;
    }
};
struct Epi {
    int mode;
    bf16_t* O; int ldc;
    bf16_t* O2;
    float* rs2;
    const bf16_t* zsrc; const float* pscale;
    const float* xres; const float* gate; float* out;
    const float* lng; const float* lnb; const float* mod1; bf16_t* xm1; float* rstat; const XcdBarrier* xb;
    __device__ __forceinline__ void fused_ln(f32x4 (&acc)[2][2][4][2], const Unit& u, int wr, int wc, int fr, int fq, LAS unsigned char* lds) const {
        asm volatile("" : "+v"(fr), "+v"(fq));
        const int tid = threadIdx.x;
        LAS float* part = (LAS float*)lds;
        LAS float* st = (LAS float*)(lds + 8192);
        const int row0 = u.pm * BM + wr * 64 + fr, col0 = u.pn * BM + wc * 32 + 8 * fq; const int b = (u.pm * BM) >> 11;
        { f32x4 gv[2][2];
#pragma unroll
          for (int bj = 0; bj < 2; ++bj)
#pragma unroll
              for (int n = 0; n < 2; ++n) gv[bj][n] = *(const f32x4*)(gate + (size_t)b * 6144 + 4096 + col0 + bj * HALF + n * 4);
#pragma unroll
          for (int ai = 0; ai < 2; ++ai)
#pragma unroll
              for (int m = 0; m < 4; ++m) { const size_t off = (size_t)(row0 + ai * HALF + m * 16) * 2048 + col0; float s = 0.f, q = 0.f;
#pragma unroll
                  for (int bj = 0; bj < 2; ++bj)
#pragma unroll
                      for (int n = 0; n < 2; ++n) { const f32x4 xr = __builtin_nontemporal_load((const f32x4*)(xres + off + bj * HALF + n * 4));
                          const f32x4 t = xr * 1.41421356237f + gv[bj][n] * acc[ai][bj][m][n]; acc[ai][bj][m][n] = t;
                          s += (t[0] + t[1]) + (t[2] + t[3]); q += (t[0] * t[0] + t[1] * t[1]) + (t[2] * t[2] + t[3] * t[3]); }
                  s = rows_sum(s); q = rows_sum(q);
                  if (fq == 0) { const int rl = ai * HALF + wr * 64 + m * 16 + fr; part[(wc * 256 + rl) * 2] = s; part[(wc * 256 + rl) * 2 + 1] = q; }
                  if (m & 1) asm volatile("" ::: "memory"); } }
        __syncthreads();
        if (tid < 256) { const float s = (part[tid * 2] + part[(256 + tid) * 2]) + (part[(512 + tid) * 2] + part[(768 + tid) * 2]);
            const float q = (part[tid * 2 + 1] + part[(256 + tid) * 2 + 1]) + (part[(512 + tid) * 2 + 1] + part[(768 + tid) * 2 + 1]);
            float* dst = rstat + ((size_t)(u.pm * BM + tid) * 8 + u.pn) * 2; dst[0] = s; dst[1] = q; }
        xcd_barrier(*xb);
        if (tid < 256) { const float* src = rstat + (size_t)(u.pm * BM + tid) * 16; float s = 0.f, q = 0.f;
#pragma unroll
            for (int j = 0; j < 8; ++j) { s += src[2 * j]; q += src[2 * j + 1]; }
            const float mu = s * (1.f / 2048.f); const float var = fmaxf(q * (1.f / 2048.f) - mu * mu, 0.f);
            st[tid * 2] = mu; st[tid * 2 + 1] = rsqrtf(var + 1e-5f); }
        __syncthreads();
        { f32x4 lg[2][2], lb[2][2];
#pragma unroll
          for (int bj = 0; bj < 2; ++bj)
#pragma unroll
              for (int n = 0; n < 2; ++n) { lg[bj][n] = *(const f32x4*)(lng + col0 + bj * HALF + n * 4); lb[bj][n] = *(const f32x4*)(lnb + col0 + bj * HALF + n * 4); }
          f32x4 msh[2][2], msc[2][2];
#pragma unroll
          for (int bj = 0; bj < 2; ++bj)
#pragma unroll
              for (int n = 0; n < 2; ++n) { if (xm1) { const float* mp = mod1 + (size_t)b * 6144 + col0 + bj * HALF + n * 4; msh[bj][n] = *(const f32x4*)mp; msc[bj][n] = *(const f32x4*)(mp + 2048) + 1.f; }
                  else { msh[bj][n] = (f32x4){0.f, 0.f, 0.f, 0.f}; msc[bj][n] = msh[bj][n]; } }
#pragma unroll
          for (int ai = 0; ai < 2; ++ai)
#pragma unroll
              for (int m = 0; m < 4; ++m) { const int rl = ai * HALF + wr * 64 + m * 16 + fr; const float mu = st[rl * 2], rs = st[rl * 2 + 1];
                  const size_t off = (size_t)(row0 + ai * HALF + m * 16) * 2048 + col0;
#pragma unroll
                  for (int bj = 0; bj < 2; ++bj) { f32x4 y[2];
#pragma unroll
                      for (int n = 0; n < 2; ++n) { y[n] = (acc[ai][bj][m][n] - mu) * rs * lg[bj][n] + lb[bj][n]; *(f32x4*)(out + off + bj * HALF + n * 4) = y[n]; }
                      if (xm1) { const f32x4 x0 = y[0] * msc[bj][0] + msh[bj][0], x1 = y[1] * msc[bj][1] + msh[bj][1];
                          u32x4 w; w[0] = cvt_pk_bf16(x0[0], x0[1]); w[1] = cvt_pk_bf16(x0[2], x0[3]); w[2] = cvt_pk_bf16(x1[0], x1[1]); w[3] = cvt_pk_bf16(x1[2], x1[3]);
                          *(u32x4*)(xm1 + off + bj * HALF) = w; } }
                  asm volatile("" ::: "memory"); } }
    }
    __device__ __forceinline__ void operator()(const f32x4 (&acc)[2][2][4][2], const Unit& u, int wr, int wc, int fr, int fq) const {
        asm volatile("" : "+v"(fr), "+v"(fq));
        if (mode == 0) {
            const int row0 = u.pm * BM + wr * 64 + fr, col0 = u.pn * BM + wc * 32 + 8 * fq;
#pragma unroll
            for (int ai = 0; ai < 2; ++ai)
#pragma unroll
                for (int m = 0; m < 4; ++m) { bf16_t* rowp = O + (size_t)(row0 + ai * HALF + m * 16) * ldc + col0; float ss = 0.f, qq = 0.f;
#pragma unroll
                    for (int bj = 0; bj < 2; ++bj) { const f32x4 v0 = acc[ai][bj][m][0], v1 = acc[ai][bj][m][1];
                        u32x4 w; w[0] = cvt_pk_bf16(v0[0], v0[1]); w[1] = cvt_pk_bf16(v0[2], v0[3]); w[2] = cvt_pk_bf16(v1[0], v1[1]); w[3] = cvt_pk_bf16(v1[2], v1[3]);
                        *(u32x4*)(rowp + bj * HALF) = w;
                        ss += ((v0[0] + v0[1]) + (v0[2] + v0[3])) + ((v1[0] + v1[1]) + (v1[2] + v1[3]));
                        qq += ((v0[0] * v0[0] + v0[1] * v0[1]) + (v0[2] * v0[2] + v0[3] * v0[3])) + ((v1[0] * v1[0] + v1[1] * v1[1]) + (v1[2] * v1[2] + v1[3] * v1[3])); }
                    if (rs2 && (u.pn >> 3) == 1) { ss += __shfl_xor(ss, 16); qq += __shfl_xor(qq, 16); ss += __shfl_xor(ss, 32); qq += __shfl_xor(qq, 32);
                        if (fq == 0) { float* d = rs2 + ((size_t)(row0 + ai * HALF + m * 16) * 32 + (u.pn - 8) * 4 + wc) * 2; d[0] = ss; d[1] = qq; } } }
        } else if (mode == 3) {
            const int row0 = u.pm * BM + wr * 64 + fr;
            if (u.pn < 16) { const int col0 = u.pn * 128 + wc * 32 + 8 * fq;
#pragma unroll
                for (int ai = 0; ai < 2; ++ai)
#pragma unroll
                    for (int m = 0; m < 4; ++m) { const f32x4 u0 = acc[ai][0][m][0], u1 = acc[ai][0][m][1], z0 = acc[ai][1][m][0], z1 = acc[ai][1][m][1]; float o[8];
#pragma unroll
                        for (int q = 0; q < 4; ++q) { o[q] = u0[q] * silu_f(z0[q]); o[4 + q] = u1[q] * silu_f(z1[q]); }
                        *(u32x4*)(O + (size_t)(row0 + ai * HALF + m * 16) * 2048 + col0) = pack8(o); }
            } else { const int col0 = (u.pn - 16) * BM + wc * 32 + 8 * fq;
#pragma unroll
                for (int ai = 0; ai < 2; ++ai)
#pragma unroll
                    for (int m = 0; m < 4; ++m) { bf16_t* rowp = O2 + (size_t)(row0 + ai * HALF + m * 16) * 2048 + col0; float ss = 0.f, qq = 0.f;
#pragma unroll
                        for (int bj = 0; bj < 2; ++bj) { const f32x4 v0 = acc[ai][bj][m][0], v1 = acc[ai][bj][m][1];
                            u32x4 w; w[0] = cvt_pk_bf16(v0[0], v0[1]); w[1] = cvt_pk_bf16(v0[2], v0[3]); w[2] = cvt_pk_bf16(v1[0], v1[1]); w[3] = cvt_pk_bf16(v1[2], v1[3]);
                            *(u32x4*)(rowp + bj * HALF) = w;
                            ss += ((v0[0] + v0[1]) + (v0[2] + v0[3])) + ((v1[0] + v1[1]) + (v1[2] + v1[3]));
                            qq += ((v0[0] * v0[0] + v0[1] * v0[1]) + (v0[2] * v0[2] + v0[3] * v0[3])) + ((v1[0] * v1[0] + v1[1] * v1[1]) + (v1[2] * v1[2] + v1[3] * v1[3])); }
                        ss = rows_sum(ss); qq = rows_sum(qq);
                        if (fq == 0) { float* d = rs2 + ((size_t)(row0 + ai * HALF + m * 16) * 32 + (u.pn - 16) * 4 + wc) * 2; d[0] = ss; d[1] = qq; } } }
        } else if (mode == 1) {
            const int g = u.pn; const int row0 = u.pm * BM + wr * 64 + fr, cg0 = wc * 32 + 8 * fq;
#pragma unroll
            for (int bj = 0; bj < 2; ++bj) { const int cg = cg0 + bj * HALF;
                const f32x4 ps0 = *(const f32x4*)(pscale + g * 256 + cg), ps1 = *(const f32x4*)(pscale + g * 256 + cg + 4);
#pragma unroll
                for (int ai = 0; ai < 2; ++ai)
#pragma unroll
                    for (int m = 0; m < 4; ++m) { const size_t row = (size_t)(row0 + ai * HALF + m * 16);
                        const u32x4 zw = *(const u32x4*)(zsrc + row * 7168 + 6144 + g * 256 + cg); float z[8]; unpack8(zw, z);
                        const f32x4 v0 = acc[ai][bj][m][0], v1 = acc[ai][bj][m][1]; float o[8];
#pragma unroll
                        for (int q = 0; q < 4; ++q) { o[q] = v0[q] * ps0[q] * silu_f(z[q]); o[4 + q] = v1[q] * ps1[q] * silu_f(z[4 + q]); }
                        *(u32x4*)(O + row * 2048 + 1024 + g * 256 + cg) = pack8(o);
                        if (m == 3) asm volatile("" ::: "memory"); } }
        } else {
            const int row0 = u.pm * BM + wr * 64 + fr, col0 = u.pn * BM + wc * 32 + 8 * fq; const int b = (u.pm * BM) >> 11;
            f32x4 gv[2][2];
#pragma unroll
            for (int bj = 0; bj < 2; ++bj)
#pragma unroll
                for (int n = 0; n < 2; ++n) gv[bj][n] = *(const f32x4*)(gate + (size_t)b * 6144 + 4096 + col0 + bj * HALF + n * 4);
#pragma unroll
            for (int ai = 0; ai < 2; ++ai)
#pragma unroll
                for (int m = 0; m < 4; ++m) { const size_t off = (size_t)(row0 + ai * HALF + m * 16) * 2048 + col0;
#pragma unroll
                    for (int bj = 0; bj < 2; ++bj)
#pragma unroll
                        for (int n = 0; n < 2; ++n) { const f32x4 xr = *(const f32x4*)(xres + off + bj * HALF + n * 4);
                            *(f32x4*)(out + off + bj * HALF + n * 4) = xr * 1.41421356237f + gv[bj][n] * acc[ai][bj][m][n]; } }
        }
    }
};

__device__ __forceinline__ void gemm_phase(LAS unsigned char* lds, const Gemm g, const Sched& S, const Epi& E) {
    const int tid = threadIdx.x, wid = __builtin_amdgcn_readfirstlane(tid >> 6), lane = tid & 63, wr = wid >> 2, wc = wid & 3, fr = lane & 15, fq = lane >> 4;
    const int K = g.K, nt = K / BK; const bool perm = true;
    unsigned voffA[2], voffB[2];
#pragma unroll
    for (int i = 0; i < 2; ++i) { int R, C; stage_rc(tid * 16 + i * 8192, R, C); const int Rb = perm ? ((R & ~31) + perm32(R & 31)) : R;
        voffA[i] = (unsigned)(R * g.lda + C) * 2u; voffB[i] = (unsigned)(Rb * g.ldb + C) * 2u; }
    const size_t kstep = (size_t)(BK * 2);
    const size_t hstepA = (size_t)HALF * g.lda * 2, hstepB = (size_t)HALF * g.ldb * 2;
    const unsigned ldsw = (unsigned)wid * 1024u;
    const int aoff = lds_byte(wr * 64 + fr, fq * 8), boff = lds_byte(wc * 32 + fr, fq * 8);
#define PG8_SA(b, h) (((b) * 2 + (h)) * HTB)
#define PG8_SB(b, h) ((4 + (b) * 2 + (h)) * HTB)
#define PG8_STAGE(bufoff, gbase, voff) do { _Pragma("unroll") for (int _i = 0; _i < 2; ++_i) \
        __builtin_amdgcn_global_load_lds((const unsigned*)((const char*)(gbase) + (voff)[_i]), (LAS unsigned*)(lds + (bufoff) + ldsw + _i * 8192), 16, 0, 0); } while (0)
#define PG8_LDA(dst, b, h) do { _Pragma("unroll") for (int m = 0; m < 4; ++m) _Pragma("unroll") for (int k = 0; k < 2; ++k) dst[m][k] = *(const LAS bf16x8*)(lds + PG8_SA(b, h) + aoff + m * 2048 + k * 1024); } while (0)
#define PG8_LDB(dst, b, h) do { _Pragma("unroll") for (int n = 0; n < 2; ++n) _Pragma("unroll") for (int k = 0; k < 2; ++k) dst[n][k] = *(const LAS bf16x8*)(lds + PG8_SB(b, h) + boff + n * 2048 + k * 1024); } while (0)
#define PG8_MMA(ai, bj, At, Bt) do { __builtin_amdgcn_s_setprio(1); _Pragma("unroll") for (int m = 0; m < 4; ++m) _Pragma("unroll") for (int n = 0; n < 2; ++n) _Pragma("unroll") for (int k = 0; k < 2; ++k) \
        acc[ai][bj][m][n] = __builtin_amdgcn_mfma_f32_16x16x32_bf16(Bt[n][k], At[m][k], acc[ai][bj][m][n], 0, 0, 0); __builtin_amdgcn_s_setprio(0); } while (0)
#define PG8_WAIT_V(n) asm volatile("s_waitcnt vmcnt(" #n ")" ::: "memory")
#define PG8_WAIT_L(n) asm volatile("s_waitcnt lgkmcnt(" #n ")" ::: "memory")
#define PG8_BAR __builtin_amdgcn_s_barrier()
#define PG8_SCHED __builtin_amdgcn_sched_barrier(0)
#define PG8_APTR(u) ((const char*)g.A + ((size_t)(u).pm * BM * g.lda + (size_t)(u).pn * g.acol) * 2)
#define PG8_BPTR(u) ((const char*)g.Bt + (size_t)(u).pn * BM * g.ldb * 2)
    Unit cur, nxt; int ui = 0;
    if (!S.next(0, cur)) return;
    f32x4 acc[2][2][4][2];
#pragma unroll
    for (int a = 0; a < 2; ++a)
#pragma unroll
        for (int b = 0; b < 2; ++b)
#pragma unroll
            for (int m = 0; m < 4; ++m)
#pragma unroll
                for (int n = 0; n < 2; ++n) acc[a][b][m][n] = (f32x4){0.f, 0.f, 0.f, 0.f};
    bf16x8 At[4][2], B0[2][2], B1[2][2];
    const char* cA = PG8_APTR(cur); const char* cB = PG8_BPTR(cur);
#if PG8_SP2
    PG8_STAGE(PG8_SB(0, 0), cB, voffB); PG8_STAGE(PG8_SB(0, 1), cB + hstepB, voffB); PG8_STAGE(PG8_SA(0, 0), cA, voffA); PG8_STAGE(PG8_SA(0, 1), cA + hstepA, voffA);
    if (wr == 1) PG8_BAR;
    PG8_WAIT_V(2); PG8_BAR;
    PG8_STAGE(PG8_SB(1, 0), cB + kstep, voffB); PG8_STAGE(PG8_SA(1, 0), cA + kstep, voffA); PG8_STAGE(PG8_SB(1, 1), cB + hstepB + kstep, voffB);
    PG8_WAIT_V(6); PG8_BAR;
#else
    PG8_STAGE(PG8_SB(0, 0), cB, voffB); PG8_STAGE(PG8_SA(0, 0), cA, voffA); PG8_STAGE(PG8_SB(0, 1), cB + hstepB, voffB); PG8_STAGE(PG8_SA(0, 1), cA + hstepA, voffA);
    if (wr == 1) PG8_BAR;
    PG8_WAIT_V(4); PG8_BAR;
    PG8_STAGE(PG8_SB(1, 0), cB + kstep, voffB); PG8_STAGE(PG8_SA(1, 0), cA + kstep, voffA); PG8_STAGE(PG8_SB(1, 1), cB + hstepB + kstep, voffB);
    PG8_WAIT_V(6); PG8_BAR;
#endif
    for (;;) {
        const bool has_next = S.next(ui + 1, nxt);
        const char* nA = has_next ? PG8_APTR(nxt) : cA; const char* nB = has_next ? PG8_BPTR(nxt) : cB;
        for (int t = 0; t < nt; t += 2) {
            const bool last = (t == nt - 2);
            const char* a1 = cA + (size_t)(t + 1) * kstep;
            const char* a2 = last ? nA : cA + (size_t)(t + 2) * kstep; const char* b2 = last ? nB : cB + (size_t)(t + 2) * kstep;
            const char* a3 = a2 + kstep; const char* b3 = b2 + kstep;
#if PG8_SP2
            PG8_LDB(B0, 0, 0); PG8_LDB(B1, 0, 1); PG8_SCHED; PG8_LDA(At, 0, 0); PG8_STAGE(PG8_SA(1, 1), a1 + hstepA, voffA);
            PG8_WAIT_V(8); PG8_WAIT_L(0); PG8_BAR; PG8_MMA(0, 0, At, B0); PG8_MMA(0, 1, At, B1); PG8_BAR; PG8_SCHED;
            PG8_LDA(At, 0, 1); PG8_STAGE(PG8_SB(0, 0), b2, voffB); PG8_STAGE(PG8_SB(0, 1), b2 + hstepB, voffB); PG8_STAGE(PG8_SA(0, 0), a2, voffA);
            PG8_WAIT_V(8); PG8_WAIT_L(0); PG8_BAR; PG8_MMA(1, 0, At, B0); PG8_MMA(1, 1, At, B1); PG8_BAR; PG8_SCHED;
            PG8_LDB(B0, 1, 0); PG8_LDB(B1, 1, 1); PG8_SCHED; PG8_LDA(At, 1, 0); PG8_STAGE(PG8_SA(0, 1), a2 + hstepA, voffA);
            PG8_WAIT_V(8); PG8_WAIT_L(0); PG8_BAR; PG8_MMA(0, 0, At, B0); PG8_MMA(0, 1, At, B1); PG8_BAR; PG8_SCHED;
            PG8_LDA(At, 1, 1); PG8_STAGE(PG8_SB(1, 0), b3, voffB); PG8_STAGE(PG8_SB(1, 1), b3 + hstepB, voffB); PG8_STAGE(PG8_SA(1, 0), a3, voffA);
            PG8_WAIT_V(8); PG8_WAIT_L(0); PG8_BAR; PG8_MMA(1, 0, At, B0); PG8_MMA(1, 1, At, B1); PG8_BAR; PG8_SCHED;
#else
            PG8_LDB(B0, 0, 0); PG8_SCHED; PG8_LDA(At, 0, 0); PG8_STAGE(PG8_SA(1, 1), a1 + hstepA, voffA);
            PG8_WAIT_L(8); PG8_BAR; PG8_WAIT_L(0); PG8_MMA(0, 0, At, B0); PG8_BAR; PG8_SCHED;
            PG8_LDB(B1, 0, 1); PG8_STAGE(PG8_SB(0, 0), b2, voffB);
            PG8_BAR; PG8_WAIT_L(0); PG8_MMA(0, 1, At, B1); PG8_BAR;
            PG8_LDA(At, 0, 1); PG8_STAGE(PG8_SA(0, 0), a2, voffA);
            PG8_BAR; PG8_WAIT_L(0); PG8_MMA(1, 0, At, B0); PG8_BAR; PG8_SCHED;
            PG8_STAGE(PG8_SB(0, 1), b2 + hstepB, voffB);
            PG8_WAIT_V(6); PG8_BAR; PG8_MMA(1, 1, At, B1); PG8_BAR;
            PG8_LDB(B0, 1, 0); PG8_SCHED; PG8_LDA(At, 1, 0); PG8_STAGE(PG8_SA(0, 1), a2 + hstepA, voffA);
            PG8_WAIT_L(8); PG8_BAR; PG8_WAIT_L(0); PG8_MMA(0, 0, At, B0); PG8_BAR; PG8_SCHED;
            PG8_LDB(B1, 1, 1); PG8_STAGE(PG8_SB(1, 0), b3, voffB);
            PG8_BAR; PG8_WAIT_L(0); PG8_MMA(0, 1, At, B1); PG8_BAR;
            PG8_LDA(At, 1, 1); PG8_STAGE(PG8_SA(1, 0), a3, voffA);
            PG8_BAR; PG8_WAIT_L(0); PG8_MMA(1, 0, At, B0); PG8_BAR; PG8_SCHED;
            PG8_STAGE(PG8_SB(1, 1), b3 + hstepB, voffB);
            PG8_WAIT_V(6); PG8_BAR; PG8_MMA(1, 1, At, B1); PG8_BAR;
#endif
        }
        if (g.align && wr == 0) PG8_BAR;
        if (E.mode != 2) E(acc, cur, wr, wc, fr, fq);
        if (!has_next) break;
#pragma unroll
        for (int a = 0; a < 2; ++a)
#pragma unroll
            for (int b = 0; b < 2; ++b)
#pragma unroll
                for (int m = 0; m < 4; ++m)
#pragma unroll
                    for (int n = 0; n < 2; ++n) acc[a][b][m][n] = (f32x4){0.f, 0.f, 0.f, 0.f};
        cur = nxt; cA = nA; cB = nB; ++ui;
        if (g.align && wr == 1) PG8_BAR;
    }
    PG8_WAIT_V(0);
    if (!g.align && wr == 0) PG8_BAR;
    PG8_BAR;
    if (E.mode == 2) E.fused_ln(acc, cur, wr, wc, fr, fq, lds);
}
}

struct TrDesc { const float* src; bf16_t* dst; int ldsrc, lddst, k0, n0s, n0d; };
__device__ __forceinline__ TrDesc tr_desc(const Params& p, int set, int q) {
    TrDesc d; int kg;
    if (set == 0) {
        if (q < 896) { const int nt = q >> 3; kg = q & 7; d.src = p.w_in_even; d.ldsrc = 7184; d.n0d = nt * 64; d.n0s = d.n0d + (nt >= 80 ? 16 : 0); d.dst = (bf16_t*)(p.ws + OFF_WINE); d.lddst = 2048; }
        else if ((q -= 896) < 256) { const int nt = q >> 3; kg = q & 7; d.src = p.w_out_even; d.ldsrc = 2048; d.n0d = d.n0s = nt * 64; d.dst = (bf16_t*)(p.ws + OFF_WOUTE); d.lddst = 2048; }
        else { q -= 256; const int g = q >> 2, nt = q & 3; kg = 0; d.src = p.pool_w + g * 65536; d.ldsrc = 256; d.n0d = d.n0s = nt * 64; d.dst = (bf16_t*)(p.ws + OFF_POOLW) + g * 65536; d.lddst = 256; }
    } else {
        if (q < 768) { const int nt = q >> 3; kg = q & 7; d.src = p.w_in_odd; d.ldsrc = 6144; d.n0d = nt * 64; d.dst = (bf16_t*)(p.ws + OFF_WINO); d.lddst = 2048;
            const int pnp = nt >> 2, within = (nt & 3) * 64;
            d.n0s = pnp < 16 ? ((within >> 7) ? 4096 : 0) + pnp * 128 + (within & 127) : 2048 + (pnp - 16) * 256 + within; }
        else { q -= 768; const int nt = q >> 3; kg = q & 7; d.src = p.w_out_odd; d.ldsrc = 2048; d.n0d = d.n0s = nt * 64; d.dst = (bf16_t*)(p.ws + OFF_WOUTO); d.lddst = 2048; }
    }
    d.k0 = kg * 256; return d;
}
__device__ __forceinline__ void tr_loop(const Params& p, LAS unsigned char* lds, int set, int q0, int qend, int stride) {
    const int tid = threadIdx.x; LAS float* lf = (LAS float*)lds;
    const int kr = tid >> 4, c4 = tid & 15, n = tid >> 3, kseg = tid & 7;
    f32x4 v[8];
    int q = q0;
    if (q < qend) { const TrDesc d = tr_desc(p, set, q);
#pragma unroll
        for (int ps = 0; ps < 8; ++ps) v[ps] = __builtin_nontemporal_load((const f32x4*)(d.src + (size_t)(d.k0 + kr + 32 * ps) * d.ldsrc + d.n0s + c4 * 4)); }
    while (q < qend) {
#pragma unroll
        for (int ps = 0; ps < 8; ++ps)
#pragma unroll
            for (int i = 0; i < 4; ++i) lf[(kr + 32 * ps) * 65 + c4 * 4 + i] = v[ps][i];
        __syncthreads();
        const int qn = q + stride;
        if (qn < qend) { const TrDesc d = tr_desc(p, set, qn);
#pragma unroll
            for (int ps = 0; ps < 8; ++ps) v[ps] = __builtin_nontemporal_load((const f32x4*)(d.src + (size_t)(d.k0 + kr + 32 * ps) * d.ldsrc + d.n0s + c4 * 4)); }
        { const TrDesc d = tr_desc(p, set, q);
#pragma unroll
          for (int qq = 0; qq < 4; ++qq) { float f[8];
#pragma unroll
              for (int jj = 0; jj < 8; ++jj) f[jj] = lf[(kseg * 32 + qq * 8 + jj) * 65 + n];
              *(u32x4*)(d.dst + (size_t)(d.n0d + n) * d.lddst + d.k0 + kseg * 32 + qq * 8) = pack8(f); } }
        __syncthreads();
        q = qn;
    }
}

__device__ __forceinline__ void phase_prep(const Params& p, LAS unsigned char* lds, int bid, int nb) {
    const int tid = threadIdx.x;
    LAS float* lf = (LAS float*)lds;
    float* modp = (float*)(p.ws + OFF_MODP);
    constexpr int NT_ADA = 192, NT_TR = 896 + 256 + 16, NT_SP = 32;
    for (int t = bid; t < NT_ADA; t += nb) {
        {
            const int l = t / 96, jblk = (t % 96) / 8, ks = t % 8;
            for (int e = tid; e < 5 * 256; e += 512) { const int r = e >> 8, kk = e & 255, k = ks * 256 + kk; const float cv = r < 4 ? p.c[r * 2048 + k] : p.cctx[k]; lf[e] = silu_f(cv); }
            __syncthreads();
            const int sub = tid >> 7, ct = tid & 127, j = jblk * 512 + ct * 4;
            float acc[5][4];
#pragma unroll
            for (int r = 0; r < 5; ++r)
#pragma unroll
                for (int i = 0; i < 4; ++i) acc[r][i] = 0.f;
            const float* wp = p.ada_w + ((size_t)l * 2048 + ks * 256 + sub * 64) * 6144 + j;
#pragma unroll 8
            for (int kk = 0; kk < 64; ++kk) { const f32x4 w = __builtin_nontemporal_load((const f32x4*)(wp + (size_t)kk * 6144));
#pragma unroll
                for (int r = 0; r < 5; ++r) { const float s = lf[r * 256 + sub * 64 + kk];
#pragma unroll
                    for (int i = 0; i < 4; ++i) acc[r][i] += s * w[i]; } }
            __syncthreads();
            LAS float* red = lf + 2048;
#pragma unroll
            for (int r = 0; r < 5; ++r)
#pragma unroll
                for (int i = 0; i < 4; ++i) red[(sub * 5 + r) * 512 + ct * 4 + i] = acc[r][i];
            __syncthreads();
            for (int e = tid; e < 2560; e += 512) { const int r = e >> 9, jj = e & 511;
                const float s = red[(0 + r) * 512 + jj] + red[(5 + r) * 512 + jj] + red[(10 + r) * 512 + jj] + red[(15 + r) * 512 + jj];
                modp[((size_t)(ks * 2 + l) * 5 + r) * 6144 + jblk * 512 + jj] = s; }
            __syncthreads();
        }
    }
    { const int rot = (bid + nb - (NT_ADA % nb)) % nb; tr_loop(p, lds, 0, rot, NT_TR, nb); }
    for (int t = bid; t < NT_SP; t += nb) {
        {
            const int s = t; const size_t e0 = (size_t)s * 4096 + tid * 8;
            const f32x4 a = *(const f32x4*)(p.w_sp + e0), b = *(const f32x4*)(p.w_sp + e0 + 4);
            float f[8] = {a[0], a[1], a[2], a[3], b[0], b[1], b[2], b[3]};
            *(u32x4*)((bf16_t*)(p.ws + OFF_WSP) + e0) = pack8(f);
        }
    }
}

__device__ __forceinline__ void phase_mod0(const Params& p, LAS unsigned char* lds, int bid, int nb) {
    const int tid = threadIdx.x, lane = tid & 63, wid = tid >> 6;
    const float* modp = (const float*)(p.ws + OFF_MODP);
    float* mod = (float*)(p.ws + OFF_MOD);
    for (int e = bid * 512 + tid; e < 61440; e += nb * 512) { const int l = e / 30720, rem = e % 30720, r = rem / 6144, j = rem % 6144;
        float s = p.ada_b[l * 6144 + j];
#pragma unroll
        for (int ks = 0; ks < 8; ++ks) s += modp[((size_t)(ks * 2 + l) * 5 + r) * 6144 + j];
        mod[e] = s; }
    const int c0 = tid * 4;
    float wg[4][16];
#pragma unroll
    for (int i = 0; i < 4; ++i)
#pragma unroll
        for (int g4 = 0; g4 < 4; ++g4) { const f32x4 w4 = *(const f32x4*)(p.w_in_even + (size_t)(c0 + i) * 7184 + 5120 + g4 * 4);
#pragma unroll
            for (int q = 0; q < 4; ++q) wg[i][g4 * 4 + q] = w4[q]; }
    LAS float* part = (LAS float*)lds;
    bf16_t* XM = (bf16_t*)(p.ws + OFF_XM); float* GATES = (float*)(p.ws + OFF_GATES);
    for (int t = bid; t < 256; t += nb) {
        const int r0 = t * 36; int curmr = -1; float sh[4] = {0.f, 0.f, 0.f, 0.f}, sc[4] = {0.f, 0.f, 0.f, 0.f};
        f32x4 xn[4], xn2[4];
#pragma unroll
        for (int u = 0; u < 4; ++u) { const int r = r0 + u; const float* src = r < 8192 ? p.x + (size_t)r * 2048 : p.ctx + (size_t)(r - 8192) * 2048; xn[u] = __builtin_nontemporal_load((const f32x4*)(src + c0)); }
#pragma unroll
        for (int u = 0; u < 4; ++u) { const int r = r0 + 4 + u; const float* src = r < 8192 ? p.x + (size_t)r * 2048 : p.ctx + (size_t)(r - 8192) * 2048; xn2[u] = __builtin_nontemporal_load((const f32x4*)(src + c0)); }
        for (int rr = 0; rr < 36; rr += 4) {
            const int rb = r0 + rr; const int mr = rb < 8192 ? (rb >> 11) : 4;
            f32x4 xv[4];
#pragma unroll
            for (int u = 0; u < 4; ++u) { xv[u] = xn[u]; xn[u] = xn2[u]; }
            {
#pragma unroll
                for (int u = 0; u < 4; ++u) { int r = rb + 8 + u; r = r < r0 + 36 ? r : r0 + 35; const float* src = r < 8192 ? p.x + (size_t)r * 2048 : p.ctx + (size_t)(r - 8192) * 2048; xn2[u] = __builtin_nontemporal_load((const f32x4*)(src + c0)); } }
            if (mr != curmr) { curmr = mr;
#pragma unroll
                for (int i = 0; i < 4; ++i) { float a = p.ada_b[c0 + i], b2 = p.ada_b[2048 + c0 + i];
#pragma unroll
                    for (int ks = 0; ks < 8; ++ks) { a += modp[((size_t)(ks * 2) * 5 + mr) * 6144 + c0 + i]; b2 += modp[((size_t)(ks * 2) * 5 + mr) * 6144 + 2048 + c0 + i]; }
                    sh[i] = a; sc[i] = b2; } }
            float pv[4][16];
#pragma unroll
            for (int u = 0; u < 4; ++u) { float xm[4];
#pragma unroll
                for (int i = 0; i < 4; ++i) xm[i] = xv[u][i] * (1.f + sc[i]) + sh[i];
                u32x2 w; w[0] = cvt_pk_bf16(xm[0], xm[1]); w[1] = cvt_pk_bf16(xm[2], xm[3]);
                *(u32x2*)(XM + (size_t)(rb + u) * 2048 + c0) = w;
#pragma unroll
                for (int g = 0; g < 16; ++g) pv[u][g] = xm[0] * wg[0][g] + xm[1] * wg[1][g] + xm[2] * wg[2][g] + xm[3] * wg[3][g]; }
#define RS_STEP(off, n) _Pragma("unroll") for (int u = 0; u < 4; ++u) _Pragma("unroll") for (int i = 0; i < (n) / 2; ++i) { const float a_ = pv[u][i], b_ = pv[u][i + (n) / 2]; const bool up_ = (lane & (off)) != 0; \
                const float send_ = up_ ? a_ : b_, keep_ = up_ ? b_ : a_; pv[u][i] = keep_ + __shfl_xor(send_, (off)); }
            RS_STEP(32, 16) RS_STEP(16, 8) RS_STEP(8, 4) RS_STEP(4, 2)
#undef RS_STEP
            const int gidx = ((lane >> 5) & 1) * 8 + ((lane >> 4) & 1) * 4 + ((lane >> 3) & 1) * 2 + ((lane >> 2) & 1);
#pragma unroll
            for (int u = 0; u < 4; ++u) { float q = pv[u][0]; q += __shfl_xor(q, 2); q += __shfl_xor(q, 1);
                if ((lane & 3) == 0) part[((rr + u) * 8 + wid) * 16 + gidx] = q; }
        }
        __syncthreads();
        for (int e = tid; e < 36 * 16; e += 512) { const int rr = e >> 4, g = e & 15; float s = 0.f;
#pragma unroll
            for (int w = 0; w < 8; ++w) s += part[(rr * 8 + w) * 16 + g];
            GATES[(size_t)(r0 + rr) * 16 + g] = s; }
        __syncthreads();
    }
}

__device__ __forceinline__ void phase_conv(const Params& p, LAS unsigned char* lds, int bid, int nb) {
    const int tid = threadIdx.x, lane = tid & 63, wid = tid >> 6;
    LAS float* scl = (LAS float*)lds;
    LAS float* ksp = (LAS float*)(lds + 1024);
    const bf16_t* PROJ = (const bf16_t*)(p.ws + OFF_PROJ);
    const float* GATES = (const float*)(p.ws + OFF_GATES);
    float* GA = (float*)(p.ws + OFF_GA); float* GP = (float*)(p.ws + OFF_GP); float* GB = (float*)(p.ws + OFF_GB);
    float* BL = (float*)(p.ws + OFF_BL); float* PX = (float*)(p.ws + OFF_PX); float* KSUM = (float*)(p.ws + OFF_KSUM);
    bf16_t* QK = (bf16_t*)(p.ws + OFF_QK); bf16_t* KHT = (bf16_t*)(p.ws + OFF_XM); bf16_t* VT = (bf16_t*)(p.ws + OFF_VT); bf16_t* R = (bf16_t*)(p.ws + OFF_R);
    const int nmine = nb == 256 ? (bid < 64 ? 3 : (bid < 192 ? 5 : 4)) : (576 + 512 - bid + nb - 1) / nb;
    for (int it = 0; it < nmine; ++it) {
        int t;
        if (nb == 256) { const int nconv = bid < 64 ? 3 : 2; t = it < nconv ? bid + 256 * it : 576 + (bid - 64) + 192 * (it - nconv); }
        else t = bid + nb * it;
        if (t < 576) {
            const int gc = t >> 2, h = t & 3, row0 = gc * 64; int pos0, slen;
            if (gc < 128) { pos0 = (gc & 31) * 64; slen = 2048; } else { pos0 = ((gc - 128) & 3) * 64; slen = 256; }
            if (wid < 2) { const int dir = wid, row = row0 + lane;
                const float gi = GATES[(size_t)row * 16 + dir * 4 + h] + p.b_ig[dir * 4 + h];
                const float gf = GATES[(size_t)row * 16 + 8 + dir * 4 + h] + p.b_fg[dir * 4 + h];
                const float lfv = fminf(gf, 0.f) - log1pf(__expf(-fabsf(gf)));
                float bc = lfv;
                if (dir == 0) {
#pragma unroll
                    for (int off = 1; off < 64; off <<= 1) { const float v = __shfl_up(bc, off); if (lane >= off) bc += v; }
                } else {
#pragma unroll
                    for (int off = 1; off < 64; off <<= 1) { const float v = __shfl_down(bc, off); if (lane + off < 64) bc += v; }
                }
                const float a = gi - bc; float pm = a;
                if (dir == 0) {
#pragma unroll
                    for (int off = 1; off < 64; off <<= 1) { const float v = __shfl_up(pm, off); if (lane >= off) pm = fmaxf(pm, v); }
                } else {
#pragma unroll
                    for (int off = 1; off < 64; off <<= 1) { const float v = __shfl_down(pm, off); if (lane + off < 64) pm = fmaxf(pm, v); }
                }
                const float bl = __shfl(bc, dir == 0 ? 63 : 0), px = __shfl(pm, dir == 0 ? 63 : 0);
                const size_t idx = (size_t)(dir * 4 + h) * 9216 + row; GA[idx] = a; GP[idx] = pm; GB[idx] = bc;
                if (lane == 0) { BL[(dir * 4 + h) * 144 + gc] = bl; PX[(dir * 4 + h) * 144 + gc] = px; }
                scl[dir * 64 + lane] = __expf(a - px);
            }
            {
                const int cg = tid & 63, rg = tid >> 6; const bool isk = cg >= 32; const int ch = (isk ? 1024 : 0) + h * 256 + (cg & 31) * 8;
                float w0[8], w1[8], w2[8];
#pragma unroll
                for (int hq = 0; hq < 2; ++hq) { const f32x4 a0 = *(const f32x4*)(p.conv_qk + ch + hq * 4), a1 = *(const f32x4*)(p.conv_qk + 2048 + ch + hq * 4), a2 = *(const f32x4*)(p.conv_qk + 4096 + ch + hq * 4);
#pragma unroll
                    for (int i = 0; i < 4; ++i) { w0[hq * 4 + i] = a0[i]; w1[hq * 4 + i] = a1[i]; w2[hq * 4 + i] = a2[i]; } }
                float prev[8], cur[8], nxt[8];
                const int s0 = rg * 8;
                u32x4 raw[10];
#pragma unroll
                for (int ii = 0; ii < 10; ++ii) { int sr = s0 - 1 + ii; const int pp = pos0 + sr; if (pp < 0) sr += 1; if (pp >= slen) sr -= 1;
                    raw[ii] = *(const u32x4*)(PROJ + (size_t)(row0 + sr) * 7168 + ch); }
                u32x4 vw[8];
#pragma unroll
                for (int ii = 0; ii < 8; ++ii) vw[ii] = *(const u32x4*)(PROJ + (size_t)(row0 + s0 + ii) * 7168 + 2048 + h * 256 + (cg & 31) * 8);
                if (pos0 + s0 - 1 < 0) raw[0] = (u32x4){0u, 0u, 0u, 0u};
                if (pos0 + s0 + 8 >= slen) raw[9] = (u32x4){0u, 0u, 0u, 0u};
                unpack8(raw[0], prev); unpack8(raw[1], cur);
                const float osc = isk ? 0.0625f : 1.f;
                float o[8][8];
#pragma unroll
                for (int ii = 0; ii < 8; ++ii) { const int s = s0 + ii;
                    unpack8(raw[ii + 2], nxt);
#pragma unroll
                    for (int i = 0; i < 8; ++i) { const float cv = w0[i] * prev[i] + w1[i] * cur[i] + w2[i] * nxt[i]; o[ii][i] = silu_f(cv) * osc; }
                    *(u32x4*)(QK + (size_t)(row0 + s) * 2048 + ch) = pack8(o[ii]);
#pragma unroll
                    for (int i = 0; i < 8; ++i) { prev[i] = cur[i]; cur[i] = nxt[i]; }
                }
                __syncthreads();
                if (isk) { const int kl = (cg & 31) * 8;
#pragma unroll
                    for (int dir = 0; dir < 2; ++dir) { float sc[8];
#pragma unroll
                        for (int ii = 0; ii < 8; ++ii) sc[ii] = scl[dir * 64 + s0 + ii];
                        bf16_t* dst = KHT + ((size_t)((dir * 144 + gc) * 4 + h) * 256 + kl) * 64 + s0;
#pragma unroll
                        for (int i = 0; i < 8; ++i) { u32x4 w; float ks = 0.f;
#pragma unroll
                            for (int j = 0; j < 4; ++j) { const float a = o[2 * j][i] * sc[2 * j], b2 = o[2 * j + 1][i] * sc[2 * j + 1]; w[j] = cvt_pk_bf16(a, b2); ks += a + b2; }
                            *(u32x4*)(dst + (size_t)i * 64) = w;
                            ksp[(rg * 2 + dir) * 256 + kl + i] = ks; } }
                } else { bf16_t* dst = VT + ((size_t)(gc * 4 + h) * 256 + cg * 8) * 64 + s0;
#pragma unroll
                    for (int i = 0; i < 8; ++i) { u32x4 w;
#pragma unroll
                        for (int j = 0; j < 4; ++j) { const unsigned a = vw[2 * j][i >> 1], b2 = vw[2 * j + 1][i >> 1]; w[j] = (i & 1) ? ((a >> 16) | (b2 & 0xffff0000u)) : ((a & 0xffffu) | (b2 << 16)); }
                        *(u32x4*)(dst + (size_t)i * 64) = w; } }
            }
            __syncthreads();
            { const int dir = tid >> 8, k = tid & 255; float sum = 0.f;
#pragma unroll
              for (int rg = 0; rg < 8; ++rg) sum += ksp[(rg * 2 + dir) * 256 + k];
              KSUM[(size_t)((dir * 144 + gc) * 4 + h) * 256 + k] = sum; }
            __syncthreads();
        } else {
            const int tr = t - 576, seg = tr >> 2, g = tr & 3; const int row0 = seg * 64;
            LAS bf16_t* ut = (LAS bf16_t*)lds;
#pragma unroll
            for (int i = 0; i < 4; ++i) { const int e = tid + 512 * i, r = e >> 5, c = e & 31;
                *(LAS u32x4*)(ut + r * 264 + c * 8) = *(const u32x4*)(PROJ + (size_t)(row0 + r) * 7168 + 5120 + g * 256 + c * 8); }
            __syncthreads();
            { const int c8 = tid & 31, w = 2 << g; const float invw = 1.f / (float)w;
#pragma unroll
              for (int k = 0; k < 4; ++k) { const int pos = (tid >> 5) + 16 * k; const int lo = max(pos - w / 2, 0), hi = min(pos + (w - 1 - w / 2), 63);
                  float sum[8];
#pragma unroll
                  for (int q = 0; q < 8; ++q) sum[q] = 0.f;
                  for (int rr = lo; rr <= hi; ++rr) { float f[8]; unpack8(*(const LAS u32x4*)(ut + rr * 264 + c8 * 8), f);
#pragma unroll
                      for (int q = 0; q < 8; ++q) sum[q] += f[q]; }
                  float u[8]; unpack8(*(const LAS u32x4*)(ut + pos * 264 + c8 * 8), u);
                  const float inv = (hi - lo + 1 == w) ? invw : 1.f / (float)(hi - lo + 1); float o[8];
#pragma unroll
                  for (int q = 0; q < 8; ++q) o[q] = sum[q] * inv - u[q];
                  *(u32x4*)(R + (size_t)(row0 + pos) * 1024 + g * 256 + c8 * 8) = pack8(o); } }
            __syncthreads();
        }
    }
}

__device__ __forceinline__ void phase_intra(const Params& p, LAS unsigned char* lds, int bid, int nb) {
    const int tid = threadIdx.x, lane = tid & 63, wid = tid >> 6, quad = lane >> 4, l15 = lane & 15;
    LAS bf16_t* Qs = (LAS bf16_t*)lds;
    LAS bf16_t* Ks = (LAS bf16_t*)(lds + 33792);
    LAS bf16_t* Vs = (LAS bf16_t*)(lds + 67584);
    LAS bf16_t* Ps = (LAS bf16_t*)(lds + 104448);
    LAS float* fs = (LAS float*)(lds + 113664);
    LAS float* a_s = fs; LAS float* pm_s = fs + 64; LAS float* bc_s = fs + 128; LAS float* nvec = fs + 192; LAS float* rsp = fs + 448; LAS float* coef_s = fs + 576; LAS float* qn_s = fs + 640; LAS float* bl_s = fs + 704; LAS float* px_s = fs + 768;
    const float* GA = (const float*)(p.ws + OFF_GA); const float* GP = (const float*)(p.ws + OFF_GP); const float* GB = (const float*)(p.ws + OFF_GB);
    const float* BL = (const float*)(p.ws + OFF_BL); const float* PX = (const float*)(p.ws + OFF_PX); const float* KSUM = (const float*)(p.ws + OFF_KSUM);
    float* GAM = (float*)(p.ws + OFF_GAM);
    const bf16_t* QK = (const bf16_t*)(p.ws + OFF_QK); const bf16_t* VT = (const bf16_t*)(p.ws + OFF_VT);
    for (int t = bid; t < 1024; t += nb) {
        const int dir = t >> 9, b = (t >> 7) & 3, h = (t >> 5) & 3, lc = t & 31;
        const int gc = b * 32 + lc, row0 = gc * 64, dh = dir * 4 + h;
        bf16_t* Hd = (bf16_t*)(p.ws + OFF_H) + (size_t)(dir * 2) * 8192 * 1024;
        float m = 0.f, nk = 0.f; const int k = tid & 255;
        const int nprev = dir == 0 ? 4 + lc : 4 + (31 - lc);
#define INTRA_G2(i_) ((i_) < 4 ? 128 + b * 4 + (dir == 0 ? (i_) : 3 - (i_)) : b * 32 + (dir == 0 ? (i_) - 4 : 35 - (i_)))
        if (tid < nprev) { const int g2 = INTRA_G2(tid); bl_s[tid] = BL[dh * 144 + g2]; px_s[tid] = PX[dh * 144 + g2]; }
        __syncthreads();
        { int i = 0;
          for (; i + 4 <= nprev; i += 4) { float ks[4];
#pragma unroll
              for (int u = 0; u < 4; ++u) { const int g2 = INTRA_G2(i + u); ks[u] = KSUM[(size_t)((dir * 144 + g2) * 4 + h) * 256 + k]; }
#pragma unroll
              for (int u = 0; u < 4; ++u) { const float px = px_s[i + u], mm = fmaxf(px, m); const float dec = __expf(m - mm), sig = __expf(px - mm); nk = dec * nk + sig * ks[u]; m = bl_s[i + u] + mm; } }
          for (; i < nprev; ++i) { const int g2 = INTRA_G2(i); const float ksv = KSUM[(size_t)((dir * 144 + g2) * 4 + h) * 256 + k];
              const float px = px_s[i], mm = fmaxf(px, m); const float dec = __expf(m - mm), sig = __expf(px - mm); nk = dec * nk + sig * ksv; m = bl_s[i] + mm; } }
#undef INTRA_G2
        if (tid < 256) nvec[tid] = nk;
        if (tid < 64) { a_s[tid] = GA[(size_t)dh * 9216 + row0 + tid]; pm_s[tid] = GP[(size_t)dh * 9216 + row0 + tid]; bc_s[tid] = GB[(size_t)dh * 9216 + row0 + tid]; }
#pragma unroll
        for (int i = 0; i < 4; ++i) { const int e = tid + 512 * i, r = e >> 5, c = e & 31;
            *(LAS u32x4*)(Qs + r * 264 + c * 8) = *(const u32x4*)(QK + (size_t)(row0 + r) * 2048 + h * 256 + c * 8);
            *(LAS u32x4*)(Ks + r * 264 + c * 8) = *(const u32x4*)(QK + (size_t)(row0 + r) * 2048 + 1024 + h * 256 + c * 8); }
#pragma unroll
        for (int i = 0; i < 4; ++i) { const int e = tid + 512 * i, r = e >> 3, c = e & 7;
            *(LAS u32x4*)(Vs + r * 72 + c * 8) = *(const u32x4*)(VT + ((size_t)(gc * 4 + h) * 256 + r) * 64 + c * 8); }
        __syncthreads();
        {
            const int tt = wid & 3, sp = wid >> 2; float rsum = 0.f; const int tcol = tt * 16 + l15; const float pmt = pm_s[tcol];
#pragma unroll
            for (int q = 0; q < 2; ++q) { const int st = sp * 2 + q; f32x4 acc = {0.f, 0.f, 0.f, 0.f};
#pragma unroll
                for (int ks = 0; ks < 8; ++ks) { const bf16x8 a = ldfrag(Ks, 264, st * 16 + l15, ks * 32 + quad * 8); const bf16x8 bq = ldfrag(Qs, 264, tt * 16 + l15, ks * 32 + quad * 8); acc = MFMA16(a, bq, acc); }
                float pv[4];
#pragma unroll
                for (int j = 0; j < 4; ++j) { const int s = st * 16 + quad * 4 + j; const bool valid = dir == 0 ? (s <= tcol) : (s >= tcol);
                    const float e = __expf(fminf(a_s[s] - pmt, 0.f)); pv[j] = valid ? acc[j] * e : 0.f; rsum += pv[j]; }
                u32x2 w; w[0] = cvt_pk_bf16(pv[0], pv[1]); w[1] = cvt_pk_bf16(pv[2], pv[3]);
                *(LAS u32x2*)(Ps + tcol * 72 + st * 16 + quad * 4) = w; }
            rsum += __shfl_xor(rsum, 16); rsum += __shfl_xor(rsum, 32);
            if (quad == 0) rsp[sp * 64 + tcol] = rsum;
        }
        {
            const int t2 = tid >> 3, j8 = tid & 7; float qn = 0.f;
#pragma unroll
            for (int kk = 0; kk < 32; kk += 8) { float f[8]; unpack8(*(const LAS u32x4*)(Qs + t2 * 264 + j8 * 32 + kk), f);
#pragma unroll
                for (int i = 0; i < 8; ++i) qn += f[i] * nvec[j8 * 32 + kk + i]; }
            qn += __shfl_xor(qn, 1); qn += __shfl_xor(qn, 2); qn += __shfl_xor(qn, 4);
            if (j8 == 0) qn_s[t2] = qn;
        }
        __syncthreads();
        if (tid < 64) { const float mm = fmaxf(pm_s[tid], m); const float rho = __expf(pm_s[tid] - mm), wi = __expf(m - mm), thr = __expf(-bc_s[tid] - mm);
            const float den = rho * (rsp[tid] + rsp[64 + tid]) + wi * qn_s[tid]; const float Dn = fmaxf(fabsf(den), thr);
            coef_s[tid] = rho / Dn; GAM[(size_t)dh * 8192 + row0 + tid] = wi / Dn; }
        __syncthreads();
        {
#pragma unroll
            for (int v2 = 0; v2 < 2; ++v2) { const int vt_ = wid * 2 + v2;
                const bf16x8 a0 = ldfrag(Vs, 72, vt_ * 16 + l15, quad * 8), a1 = ldfrag(Vs, 72, vt_ * 16 + l15, 32 + quad * 8);
#pragma unroll
                for (int tt = 0; tt < 4; ++tt) { f32x4 acc = {0.f, 0.f, 0.f, 0.f};
                    acc = MFMA16(a0, ldfrag(Ps, 72, tt * 16 + l15, quad * 8), acc); acc = MFMA16(a1, ldfrag(Ps, 72, tt * 16 + l15, 32 + quad * 8), acc);
                    const int tq = tt * 16 + l15; const float cf = coef_s[tq];
                    { const f32x4 o = acc * cf; u32x2 w; w[0] = cvt_pk_bf16(o[0], o[1]); w[1] = cvt_pk_bf16(o[2], o[3]);
                      *(u32x2*)(Hd + (size_t)(row0 + tq) * 1024 + h * 256 + vt_ * 16 + quad * 4) = w; } } }
        }
        __syncthreads();
    }
}

struct ScanS { u32x4 q[4]; u32x4 v; float g; };
struct ScanD { bf16x8 ka[2][2]; };
__device__ __forceinline__ void phase_scan(const Params& p, LAS unsigned char* lds, int bid, int nb, bool dry) {
    if (bid >= 256) return;
    const int tid = threadIdx.x, lane = tid & 63, wid = tid >> 6, quad = lane >> 4, l15 = lane & 15;
    int slot;
    { volatile LAS unsigned* bst = (volatile LAS unsigned*)(lds + 131072); const unsigned xcc = bst[2], r = bst[3]; unsigned ov = bst[4];
      if (gridDim.x != 256) slot = bid;
      else if (ov == 0u) slot = (int)(xcc * 32u + r);
      else { unsigned* bw = (unsigned*)(p.ws + OFF_BAR); ov -= 1u; slot = 0;
             for (unsigned x = 0; x < 8u; ++x) { unsigned c = __hip_atomic_load(&bw[3600 + x], __ATOMIC_RELAXED, __HIP_MEMORY_SCOPE_AGENT); c = c < 32u ? c : 32u; const unsigned fr = 32u - c; if (ov < fr) { slot = (int)(x * 32u + c + ov); break; } ov -= fr; } } }
    const int seq = slot >> 3, vs = slot & 7, dir = seq >> 4, b = (seq >> 2) & 3, h = seq & 3, dh = dir * 4 + h;
    constexpr int SET = 55552;
    LAS float* decs = (LAS float*)(lds + 2 * SET);
    LAS float* sigs = decs + 64; LAS float* pxs = decs + 128; LAS float* bls = decs + 192;
    const float* BL = (const float*)(p.ws + OFF_BL); const float* PX = (const float*)(p.ws + OFF_PX); const float* GAM = (const float*)(p.ws + OFF_GAM);
    const bf16_t* QK = (const bf16_t*)(p.ws + OFF_QK); const bf16_t* VT = (const bf16_t*)(p.ws + OFF_VT); const bf16_t* KHT = (const bf16_t*)(p.ws + OFF_XM);
    bf16_t* Hd = (bf16_t*)(p.ws + OFF_H) + (size_t)(dir * 2 + 1) * 8192 * 1024;
    const int tt = wid & 3, vt_ = wid >> 2, tq = tt * 16 + l15;
#define SCAN_GC(i_) const int jj = dir == 0 ? (i_) : ((i_) < 4 ? 3 - (i_) : 39 - (i_)); const bool lat = jj >= 4; const int gc = lat ? b * 32 + (jj - 4) : 128 + b * 4 + jj; const int row0 = gc * 64;
    if (tid < 36) { SCAN_GC(tid) (void)row0; pxs[tid] = PX[dh * 144 + gc]; bls[tid] = BL[dh * 144 + gc]; }
    __syncthreads();
    if (tid == 0) { float m = 0.f; for (int i = 0; i < 36; ++i) { const float px = pxs[i], mm = fmaxf(px, m); decs[i] = __expf(m - mm); sigs[i] = __expf(px - mm); m = bls[i] + mm; } }
    auto issueS = [&](ScanS& S, int i0) {
        const int i = i0 < 36 ? i0 : 35;
        SCAN_GC(i)
        const int rowc = lat ? row0 : b * 2048;
        S.v = *(const u32x4*)(VT + ((size_t)(gc * 4 + h) * 256 + vs * 32) * 64 + (tid & 255) * 8);
#pragma unroll
        for (int q = 0; q < 4; ++q) { const int e = tid + 512 * q, r = e >> 5, c = e & 31; S.q[q] = *(const u32x4*)(QK + (size_t)(rowc + r) * 2048 + h * 256 + c * 8); }
        S.g = 0.f;
    };
    auto stageS = [&](ScanS& S, int i) {
        LAS unsigned char* sb = lds + (i & 1) * SET;
        *(LAS u32x4*)((LAS bf16_t*)(sb + 33792) + ((tid & 255) >> 3) * 72 + (tid & 7) * 8) = S.v;
#pragma unroll
        for (int q = 0; q < 4; ++q) { const int e = tid + 512 * q; *(LAS u32x4*)((LAS bf16_t*)sb + (e >> 5) * 264 + (e & 31) * 8) = S.q[q]; }
    };
    auto issueD = [&](ScanD& D, int i0) {
        const int i = i0 < 36 ? i0 : 35;
        SCAN_GC(i)
        const int rowc = lat ? row0 : b * 2048;
        const bf16_t* ksrc = KHT + (size_t)((dir * 144 + gc) * 4 + h) * 256 * 64;
#pragma unroll
        for (int k2 = 0; k2 < 2; ++k2) { const bf16_t* rp = ksrc + (size_t)((wid * 2 + k2) * 16 + l15) * 64 + quad * 8; D.ka[k2][0] = *(const bf16x8*)rp; D.ka[k2][1] = *(const bf16x8*)(rp + 32); }
        (void)rowc;
    };
    f32x4 C[2][2];
#pragma unroll
    for (int a = 0; a < 2; ++a)
#pragma unroll
        for (int c = 0; c < 2; ++c) C[a][c] = (f32x4){0.f, 0.f, 0.f, 0.f};
    auto step = [&](ScanD& D, ScanS& So, int i) {
        SCAN_GC(i)
        const int rowc = lat ? row0 : b * 2048;
        const LAS unsigned char* rb = lds + (i & 1) * SET; LAS unsigned char* wb = lds + ((i + 1) & 1) * SET;
        const LAS bf16_t* Qs = (const LAS bf16_t*)rb; const LAS bf16_t* Vs = (const LAS bf16_t*)(rb + 33792); const LAS bf16_t* Cr = (const LAS bf16_t*)(rb + 38400);
        LAS bf16_t* Cw = (LAS bf16_t*)(wb + 38400);
        stageS(So, i + 1);
        issueS(So, i + 3);
        const float dec = decs[i], sig = sigs[i];
        const bf16x8 vb00 = ldfrag(Vs, 72, l15, quad * 8), vb01 = ldfrag(Vs, 72, l15, 32 + quad * 8), vb10 = ldfrag(Vs, 72, 16 + l15, quad * 8), vb11 = ldfrag(Vs, 72, 16 + l15, 32 + quad * 8);
        { f32x4 acc = {0.f, 0.f, 0.f, 0.f};
            bf16x8 ca[8], qb[8];
#pragma unroll
            for (int ks = 0; ks < 8; ++ks) { ca[ks] = ldfrag(Cr, 264, vt_ * 16 + l15, ks * 32 + quad * 8); qb[ks] = ldfrag(Qs, 264, tt * 16 + l15, ks * 32 + quad * 8); }
            const float g = !lat ? 0.f : 1.f;
#pragma unroll
            for (int ks = 0; ks < 8; ++ks) acc = MFMA16(ca[ks], qb[ks], acc);
            { const f32x4 o = acc * g; u32x2 w; w[0] = cvt_pk_bf16(o[0], o[1]); w[1] = cvt_pk_bf16(o[2], o[3]);
              *(u32x2*)(Hd + (size_t)(rowc + tq) * 1024 + h * 256 + vs * 32 + vt_ * 16 + quad * 4) = w; } }
#pragma unroll
        for (int v2 = 0; v2 < 2; ++v2) { const bf16x8 b0 = v2 ? vb10 : vb00, b1 = v2 ? vb11 : vb01;
#pragma unroll
            for (int k2 = 0; k2 < 2; ++k2) { f32x4 d = {0.f, 0.f, 0.f, 0.f};
                d = MFMA16(D.ka[k2][0], b0, d); d = MFMA16(D.ka[k2][1], b1, d);
                C[k2][v2] = C[k2][v2] * dec + d * sig;
                u32x2 w; w[0] = cvt_pk_bf16(C[k2][v2][0], C[k2][v2][1]); w[1] = cvt_pk_bf16(C[k2][v2][2], C[k2][v2][3]);
                *(LAS u32x2*)(Cw + (v2 * 16 + l15) * 264 + (wid * 2 + k2) * 16 + quad * 4) = w; } }
        issueD(D, i + 2);
        asm volatile("s_waitcnt lgkmcnt(0)\n\ts_barrier" ::: "memory");
    };
    for (int e = tid; e < 2 * SET / 16; e += 512) *(LAS u32x4*)(lds + e * 16) = (u32x4){0u, 0u, 0u, 0u};
    __syncthreads();
    ScanS Sa, Sb; ScanD D0, D1;
    issueS(Sa, 0); issueD(D0, 0); issueD(D1, 1); issueS(Sb, 1);
    stageS(Sa, 0); issueS(Sa, 2);
    __syncthreads();
    for (int i = 0; i < 36; i += 2) { step(D0, Sb, i); step(D1, Sa, i + 1); }
#undef SCAN_GC
}

__device__ __forceinline__ void phase_mout(const Params& p, int it_lo, int it_hi, int wave0, int nwaves) {
    const int lane = threadIdx.x & 63;
    const bf16_t* H4 = (const bf16_t*)(p.ws + OFF_H); constexpr size_t HPL = (size_t)8192 * 1024;
    const float* GAM = (const float*)(p.ws + OFF_GAM);
    const bf16_t* PROJ = (const bf16_t*)(p.ws + OFF_PROJ); bf16_t* Y = (bf16_t*)(p.ws + OFF_QK);
    for (int it0 = it_lo + wave0; it0 < it_hi; it0 += 4 * nwaves) {
        f32x4 hf[4], hb[4]; u32x2 ow[4], zw[4]; f32x4 gg[4]; float hv[4][4], s[4], v[4];
#pragma unroll
        for (int u = 0; u < 4; ++u) { int it = it0 + u * nwaves; if (it >= it_hi) it = it0; const int row = it >> 2, h = it & 3, c = h * 256 + lane * 4;
            { const u32x2 a0 = *(const u32x2*)(H4 + (size_t)row * 1024 + c), a1 = *(const u32x2*)(H4 + HPL + (size_t)row * 1024 + c), a2 = *(const u32x2*)(H4 + 2 * HPL + (size_t)row * 1024 + c), a3 = *(const u32x2*)(H4 + 3 * HPL + (size_t)row * 1024 + c);
              const float gf = GAM[(size_t)h * 8192 + row], gb = GAM[(size_t)(4 + h) * 8192 + row];
              hf[u] = (f32x4){bflo(a0[0]) + gf * bflo(a1[0]), bfhi(a0[0]) + gf * bfhi(a1[0]), bflo(a0[1]) + gf * bflo(a1[1]), bfhi(a0[1]) + gf * bfhi(a1[1])};
              hb[u] = (f32x4){bflo(a2[0]) + gb * bflo(a3[0]), bfhi(a2[0]) + gb * bfhi(a3[0]), bflo(a2[1]) + gb * bflo(a3[1]), bfhi(a2[1]) + gb * bfhi(a3[1])}; }
            ow[u] = *(const u32x2*)(PROJ + (size_t)row * 7168 + 3072 + c); zw[u] = *(const u32x2*)(PROJ + (size_t)row * 7168 + 4096 + c);
            gg[u] = *(const f32x4*)(p.mh_g + c); }
#pragma unroll
        for (int u = 0; u < 4; ++u) { const float o[4] = {bflo(ow[u][0]), bfhi(ow[u][0]), bflo(ow[u][1]), bfhi(ow[u][1])}; s[u] = 0.f;
#pragma unroll
            for (int i = 0; i < 4; ++i) { hv[u][i] = (hf[u][i] + hb[u][i]) * sigm_f(o[i]); s[u] += hv[u][i]; } }
#pragma unroll
        for (int u = 0; u < 4; ++u) s[u] = wave_sum(s[u]);
#pragma unroll
        for (int u = 0; u < 4; ++u) { const float mu = s[u] * (1.f / 256.f); v[u] = 0.f;
#pragma unroll
            for (int i = 0; i < 4; ++i) { hv[u][i] -= mu; v[u] += hv[u][i] * hv[u][i]; } }
#pragma unroll
        for (int u = 0; u < 4; ++u) v[u] = wave_sum(v[u]);
#pragma unroll
        for (int u = 0; u < 4; ++u) { const int it = it0 + u * nwaves; if (it < it_hi) { const int row = it >> 2, h = it & 3, c = h * 256 + lane * 4;
            const float rstd = rsqrtf(v[u] * (1.f / 256.f) + 1e-5f);
            const float z[4] = {bflo(zw[u][0]), bfhi(zw[u][0]), bflo(zw[u][1]), bfhi(zw[u][1])}; float y[4];
#pragma unroll
            for (int i = 0; i < 4; ++i) y[i] = hv[u][i] * rstd * gg[u][i] * silu_f(z[i]);
            u32x2 w; w[0] = cvt_pk_bf16(y[0], y[1]); w[1] = cvt_pk_bf16(y[2], y[3]);
            *(u32x2*)(Y + (size_t)row * 2048 + c) = w; } }
    }
}

__device__ __forceinline__ void phase_ln(const Params& p, int layer, bool domod, int wave0, int nwaves) {
    const int lane = threadIdx.x & 63;
    const float* mod1 = (const float*)(p.ws + OFF_MOD) + 5 * 6144;
    bf16_t* XM1 = (bf16_t*)(p.ws + OFF_XM);
    for (int row = wave0; row < 8192; row += nwaves) { float* rp = p.out + (size_t)row * 2048; const int b = row >> 11;
        f32x4 v[8]; float s = 0.f;
#pragma unroll
        for (int i = 0; i < 8; ++i) { v[i] = *(const f32x4*)(rp + (i * 64 + lane) * 4); s += v[i][0] + v[i][1] + v[i][2] + v[i][3]; }
#pragma unroll
        for (int off = 1; off < 64; off <<= 1) s += __shfl_xor(s, off);
        const float mu = s * (1.f / 2048.f); float q = 0.f;
#pragma unroll
        for (int i = 0; i < 8; ++i) { v[i] -= mu; q += v[i][0] * v[i][0] + v[i][1] * v[i][1] + v[i][2] * v[i][2] + v[i][3] * v[i][3]; }
#pragma unroll
        for (int off = 1; off < 64; off <<= 1) q += __shfl_xor(q, off);
        const float rstd = rsqrtf(q * (1.f / 2048.f) + 1e-5f);
#pragma unroll
        for (int i = 0; i < 8; ++i) { const int col = (i * 64 + lane) * 4;
            const f32x4 g = *(const f32x4*)(p.pln_g + layer * 2048 + col), bb = *(const f32x4*)(p.pln_b + layer * 2048 + col);
            const f32x4 y = v[i] * rstd * g + bb; *(f32x4*)(rp + col) = y;
            if (domod) { const f32x4 sh = *(const f32x4*)(mod1 + (size_t)b * 6144 + col), sc = *(const f32x4*)(mod1 + (size_t)b * 6144 + 2048 + col);
                const f32x4 xm = y * (sc + 1.f) + sh; u32x2 w; w[0] = cvt_pk_bf16(xm[0], xm[1]); w[1] = cvt_pk_bf16(xm[2], xm[3]);
                *(u32x2*)(XM1 + (size_t)row * 2048 + col) = w; } }
    }
}

__device__ __forceinline__ void phase_sguln(const Params& p, LAS unsigned char* lds, int bid, int nb) {
    const int tid = threadIdx.x, lane = tid & 63, wid = tid >> 6;
    LAS bf16_t* tile = (LAS bf16_t*)lds;
    const bf16_t* PROJ1 = (const bf16_t*)(p.ws + OFF_PROJ); bf16_t* VNT = (bf16_t*)(p.ws + OFF_H);
    for (int t = bid; t < 256; t += nb) { const int b = t >> 6, n = (t >> 2) & 15, rq = t & 3; const int row0 = b * 2048 + n * 128 + rq * 32;
        u32x4 raw[4][4];
#pragma unroll
        for (int rr = 0; rr < 4; ++rr)
#pragma unroll
            for (int i = 0; i < 4; ++i) raw[rr][i] = *(const u32x4*)(PROJ1 + (size_t)(row0 + wid * 4 + rr) * 6144 + 2048 + (i * 64 + lane) * 8);
        float mu[4], rs[4];
        { float s[4];
#pragma unroll
          for (int rr = 0; rr < 4; ++rr) { s[rr] = 0.f;
#pragma unroll
              for (int i = 0; i < 4; ++i) { float f[8]; unpack8(raw[rr][i], f);
#pragma unroll
                  for (int q = 0; q < 8; ++q) s[rr] += f[q]; } }
#pragma unroll
          for (int off = 1; off < 64; off <<= 1) {
#pragma unroll
              for (int rr = 0; rr < 4; ++rr) s[rr] += __shfl_xor(s[rr], off); }
          float v[4];
#pragma unroll
          for (int rr = 0; rr < 4; ++rr)
#pragma unroll
              for (int i = 0; i < 4; ++i) asm volatile("" : "+v"(raw[rr][i]));
#pragma unroll
          for (int rr = 0; rr < 4; ++rr) { mu[rr] = s[rr] * (1.f / 2048.f); v[rr] = 0.f;
#pragma unroll
              for (int i = 0; i < 4; ++i) { float f[8]; unpack8(raw[rr][i], f);
#pragma unroll
                  for (int q = 0; q < 8; ++q) { const float d = f[q] - mu[rr]; v[rr] += d * d; } } }
#pragma unroll
          for (int off = 1; off < 64; off <<= 1) {
#pragma unroll
              for (int rr = 0; rr < 4; ++rr) v[rr] += __shfl_xor(v[rr], off); }
#pragma unroll
          for (int rr = 0; rr < 4; ++rr) rs[rr] = rsqrtf(v[rr] * (1.f / 2048.f) + 1e-5f); }
#pragma unroll
        for (int rr = 0; rr < 4; ++rr)
#pragma unroll
            for (int i = 0; i < 4; ++i) asm volatile("" : "+v"(raw[rr][i]));
#pragma unroll
        for (int half = 0; half < 2; ++half) {
#pragma unroll
            for (int ii = 0; ii < 2; ++ii) { const int i = half * 2 + ii; const int col = (i * 64 + lane) * 8;
                const f32x4 g0 = *(const f32x4*)(p.sgu_g + col), g1 = *(const f32x4*)(p.sgu_g + col + 4), b0 = *(const f32x4*)(p.sgu_b + col), b1 = *(const f32x4*)(p.sgu_b + col + 4);
                float f[4][8];
#pragma unroll
                for (int rr = 0; rr < 4; ++rr) unpack8(raw[rr][i], f[rr]);
#pragma unroll
                for (int q = 0; q < 8; ++q) { const float gq = q < 4 ? g0[q & 3] : g1[q & 3], bq = q < 4 ? b0[q & 3] : b1[q & 3];
                    float y[4];
#pragma unroll
                    for (int rr = 0; rr < 4; ++rr) y[rr] = (f[rr][q] - mu[rr]) * rs[rr] * gq + bq;
                    u32x2 w; w[0] = cvt_pk_bf16(y[0], y[1]); w[1] = cvt_pk_bf16(y[2], y[3]);
                    *(LAS u32x2*)(tile + (q * 128 + ii * 64 + lane) * 36 + wid * 4) = w; } }
            __syncthreads();
#pragma unroll
            for (int k = 0; k < 2; ++k) { const int prow = tid + 512 * k; const int c = ((prow & 127) << 3) | (prow >> 7);
                bf16_t* dst = VNT + ((size_t)((b * 16 + n) * 2048 + half * 1024 + c)) * 128 + rq * 32;
#pragma unroll
                for (int q = 0; q < 4; ++q) { const u32x2 lo = *(const LAS u32x2*)(tile + prow * 36 + q * 8), hi = *(const LAS u32x2*)(tile + prow * 36 + q * 8 + 4);
                    u32x4 w; w[0] = lo[0]; w[1] = lo[1]; w[2] = hi[0]; w[3] = hi[1]; *(u32x4*)(dst + q * 8) = w; } }
            __syncthreads();
        }
    }
}

__device__ __forceinline__ void phase_sgu(const Params& p, LAS unsigned char* lds, int bid, int nb) {
    const int tid = threadIdx.x, lane = tid & 63, wid = tid >> 6, quad = lane >> 4, l15 = lane & 15;
    LAS bf16_t* Xs = (LAS bf16_t*)lds;
    LAS bf16_t* Ws = (LAS bf16_t*)(lds + 78336);
    LAS float* st = (LAS float*)(lds + 113152);
    const bf16_t* PROJ1 = (const bf16_t*)(p.ws + OFF_PROJ); const bf16_t* WSP = (const bf16_t*)(p.ws + OFF_WSP); const float* RS2 = (const float*)(p.ws + OFF_RS2);
    bf16_t* Y1 = (bf16_t*)(p.ws + OFF_QK);
    int hloaded = -1;
    const int xrow0 = (l15 & 3) * 36 + 4 * wid + (l15 >> 2);
    for (int t = bid; t < 512; t += nb) { const int h = t & 7, n = (t >> 3) & 15, b = t >> 7; const size_t crow = (size_t)b * 2048 + n * 128;
        if (tid < 128) { const float* src = RS2 + (crow + tid) * 64; float sm = 0.f, sq = 0.f;
#pragma unroll
            for (int j = 0; j < 16; ++j) { const f32x4 v4 = *(const f32x4*)(src + 4 * j); sm += v4[0] + v4[2]; sq += v4[1] + v4[3]; }
            const float mu = sm * (1.f / 2048.f); const float var = fmaxf(sq * (1.f / 2048.f) - mu * mu, 0.f);
            st[tid * 2] = mu; st[tid * 2 + 1] = rsqrtf(var + 1e-5f); }
        if (h != hloaded) { hloaded = h;
#pragma unroll 1
            for (int i = 0; i < 4; ++i) { const int e = tid + 512 * i, r = e >> 4, c = e & 15; *(LAS u32x4*)(Ws + r * 136 + c * 8) = *(const u32x4*)(WSP + (size_t)h * 16384 + r * 128 + c * 8); } }
        const int c8 = tid & 31;
        u32x4 va[4], vb[4];
#pragma unroll
        for (int i = 0; i < 4; ++i) { const int sp = (tid >> 5) + 16 * i; const bf16_t* vp = PROJ1 + (size_t)8192 * 2048 + (crow + 2 * sp) * 2048 + h * 256 + c8 * 8; va[i] = *(const u32x4*)vp; vb[i] = *(const u32x4*)(vp + 2048); }
        float gg[8], bb[8];
        { const f32x4 g0 = *(const f32x4*)(p.sgu_g + h * 256 + c8 * 8), g1 = *(const f32x4*)(p.sgu_g + h * 256 + c8 * 8 + 4), b0 = *(const f32x4*)(p.sgu_b + h * 256 + c8 * 8), b1 = *(const f32x4*)(p.sgu_b + h * 256 + c8 * 8 + 4);
#pragma unroll
          for (int q = 0; q < 4; ++q) { gg[q] = g0[q]; gg[4 + q] = g1[q]; bb[q] = b0[q]; bb[4 + q] = b1[q]; } }
        __syncthreads();
#pragma unroll
        for (int i = 0; i < 4; ++i) { const int sp = (tid >> 5) + 16 * i; float fa[8], fb[8]; unpack8(va[i], fa); unpack8(vb[i], fb);
            const float mua = st[4 * sp], rsa = st[4 * sp + 1], mub = st[4 * sp + 2], rsb = st[4 * sp + 3];
#pragma unroll
            for (int q = 0; q < 8; ++q) { const float ya = (fa[q] - mua) * rsa * gg[q] + bb[q], yb = (fb[q] - mub) * rsb * gg[q] + bb[q];
                *(LAS unsigned*)(Xs + (q * 36 + c8) * 136 + 2 * sp) = cvt_pk_bf16(ya, yb); } }
        __syncthreads();
#pragma unroll 1
        for (int th = 0; th < 2; ++th) {
            f32x4 acc[2][4];
#pragma unroll
            for (int a = 0; a < 2; ++a)
#pragma unroll
                for (int c = 0; c < 4; ++c) acc[a][c] = (f32x4){0.f, 0.f, 0.f, 0.f};
#pragma unroll
            for (int ks = 0; ks < 4; ++ks) { const bf16x8 a0 = ldfrag(Xs, 136, xrow0, ks * 32 + quad * 8), a1 = ldfrag(Xs, 136, xrow0 + 4 * 36, ks * 32 + quad * 8);
#pragma unroll
                for (int tt = 0; tt < 4; ++tt) { const bf16x8 bw = ldfrag(Ws, 136, (th * 4 + tt) * 16 + l15, ks * 32 + quad * 8); acc[0][tt] = MFMA16(a0, bw, acc[0][tt]); acc[1][tt] = MFMA16(a1, bw, acc[1][tt]); } }
#pragma unroll
            for (int tt = 0; tt < 4; ++tt) { const int tq = (th * 4 + tt) * 16 + l15; const size_t row = crow + tq; const int c0 = h * 256 + wid * 32 + quad * 8;
                const float bias = p.b_sp[h * 128 + tq];
                float gz[8], y[8]; unpack8(*(const u32x4*)(PROJ1 + row * 2048 + c0), gz);
#pragma unroll
                for (int q = 0; q < 4; ++q) { y[q] = gz[q] * (acc[0][tt][q] + bias); y[4 + q] = gz[4 + q] * (acc[1][tt][q] + bias); }
                *(u32x4*)(Y1 + row * 2048 + c0) = pack8(y); }
        }
        __syncthreads();
    }
}

#ifndef PHASE_MASK
#define PHASE_MASK 0xFFFF
#endif
#define PH_ON(n) (((PHASE_MASK) >> (n)) & 1)
typedef const __attribute__((address_space(4))) Params* cparams_t;
__device__ __forceinline__ Params ld_params() {
#if defined(__HIP_DEVICE_COMPILE__)
    cparams_t kp = (cparams_t)__builtin_amdgcn_kernarg_segment_ptr();
    asm volatile("" : "+s"(kp));
    Params r;
    typedef const __attribute__((address_space(1))) float* gptr_t;
    const __attribute__((address_space(4))) gptr_t* sp = (const __attribute__((address_space(4))) gptr_t*)kp;
    const float** fp = (const float**)&r;
#pragma unroll
    for (int i = 0; i < (int)(sizeof(Params) / 8); ++i) fp[i] = (const float*)sp[i];
    return r;
#else
    return Params{};
#endif
}
__global__ void __launch_bounds__(512, 2) fwd_megakernel(Params p_first_arg, int ph_lo, int ph_hi, int coop) {
    extern __shared__ __attribute__((aligned(16))) unsigned char shm[];
    LAS unsigned char* lds = (LAS unsigned char*)shm;
    cg::grid_group grid = cg::this_grid();
    const int bid = blockIdx.x, nb = gridDim.x;
    volatile LAS unsigned* bst = (volatile LAS unsigned*)(lds + 131072);
    if (threadIdx.x < 2) bst[threadIdx.x] = 0u;
    __syncthreads();
    const XcdBarrier xbar = xcd_barrier_post((unsigned*)(ld_params().ws + OFF_BAR), bst);
    if (threadIdx.x == 0) {
        unsigned* bw = (unsigned*)(ld_params().ws + OFF_BAR);
        const unsigned xcc = xb_xcc_id(); const unsigned r = xb_add(&bw[3600 + xcc], 1u);
        unsigned ov = 0u; if (xcc >= 8u || r >= 32u) ov = xb_add(&bw[3620], 1u) + 1u;
        bst[2] = xcc; bst[3] = r; bst[4] = ov; }
#define GRID_SYNC() do { if (coop == 2) grid.sync(); else xcd_barrier(xbar); } while (0)
    const int gw = bid * 8 + (threadIdx.x >> 6), nw = nb * 8;
#ifndef REP_MASK
#define REP_MASK 0ull
#endif
#ifndef EXTRA_SYNCS
#define EXTRA_SYNCS 0
#endif
#define PH_REPS(n) (1 + (int)(((REP_MASK) >> (4 * (n))) & 15ull))
#define PH_BEGIN(n) if (PH_ON(n) && ph_lo <= (n) && (n) < ph_hi) for (int rep_ = 0; rep_ < PH_REPS(n); ++rep_) { const bool dry = rep_ > 0; (void)dry; if (rep_ > 0 && coop) GRID_SYNC(); const Params p = ld_params();
#define PH_END(n) } if (coop && ph_lo <= (n) && (n) + 1 < ph_hi) GRID_SYNC();
        PH_BEGIN(0) phase_prep(p, lds, bid, nb); PH_END(0)
        PH_BEGIN(1) phase_mod0(p, lds, bid, nb); PH_END(1)
        PH_BEGIN(2) { pg8::Gemm g{(const bf16_t*)(p.ws + OFF_XM), (const bf16_t*)(p.ws + OFF_WINE), 2048, 2048, 2048, 0, PG8_ALIGN};
                  pg8::Sched S{1, 32, 28, 896, nb, bid}; pg8::Epi E{}; E.mode = 0; E.O = (bf16_t*)(p.ws + OFF_PROJ); E.ldc = 7168;
                  pg8::gemm_phase(lds, g, S, E);
                  { const int first = nb == 256 ? 160 : 0, nconv = nb - first;
                    if (bid >= first) { __syncthreads(); tr_loop(p, lds, 1, bid - first, nb == 256 ? 768 : 1024, nconv); }     } } PH_END(2)
        PH_BEGIN(3) phase_conv(p, lds, bid, nb); PH_END(3)
        PH_BEGIN(4) phase_scan(p, lds, bid, nb, dry); __syncthreads(); phase_intra(p, lds, bid, nb); PH_END(4)
        PH_BEGIN(6) if (bid < 128) { pg8::Gemm g{(const bf16_t*)(p.ws + OFF_R), (const bf16_t*)(p.ws + OFF_POOLW), 1024, 256, 256, 256, 0};
                  pg8::Sched S{2, 32, 4, 128, 128, bid}; pg8::Epi E{}; E.mode = 1; E.O = (bf16_t*)(p.ws + OFF_QK); E.ldc = 2048; E.zsrc = (const bf16_t*)(p.ws + OFF_PROJ); E.pscale = p.pool_scale;
                  pg8::gemm_phase(lds, g, S, E); }
                else phase_mout(p, 0, 32768, (bid - 128) * 8 + (threadIdx.x >> 6), (nb - 128) * 8);
                PH_END(6)
        PH_BEGIN(7) { pg8::Gemm g{(const bf16_t*)(p.ws + OFF_QK), (const bf16_t*)(p.ws + OFF_WOUTE), 2048, 2048, 2048, 0, 0};
                  pg8::Sched S{0, 32, 8, 256, nb, bid}; pg8::Epi E{}; E.mode = 2; E.xres = p.x; E.gate = (const float*)(p.ws + OFF_MOD); E.out = p.out;
                  E.lng = p.pln_g; E.lnb = p.pln_b; E.mod1 = (const float*)(p.ws + OFF_MOD) + 5 * 6144; E.xm1 = (bf16_t*)(p.ws + OFF_XM); E.rstat = (float*)(p.ws + OFF_RSTAT); E.xb = &xbar;
                  pg8::gemm_phase(lds, g, S, E); } PH_END(7)
        PH_BEGIN(9) { pg8::Gemm g{(const bf16_t*)(p.ws + OFF_XM), (const bf16_t*)(p.ws + OFF_WINO), 2048, 2048, 2048, 0, PG8_ALIGN};
                  pg8::Sched S{0, 32, 24, 768, nb, bid}; pg8::Epi E{}; E.mode = 3; E.O = (bf16_t*)(p.ws + OFF_PROJ); E.O2 = (bf16_t*)(p.ws + OFF_PROJ) + (size_t)8192 * 2048; E.ldc = 2048; E.rs2 = (float*)(p.ws + OFF_RS2);
                  pg8::gemm_phase(lds, g, S, E); } PH_END(9)
        PH_BEGIN(11) if (nb == 256) { tr_loop(p, lds, 1, 768 + bid, 1024, 256); } phase_sgu(p, lds, bid, nb); PH_END(11)
        PH_BEGIN(12) { pg8::Gemm g{(const bf16_t*)(p.ws + OFF_QK), (const bf16_t*)(p.ws + OFF_WOUTO), 2048, 2048, 2048, 0, 0};
                  pg8::Sched S{0, 32, 8, 256, nb, bid}; pg8::Epi E{}; E.mode = 2; E.xres = p.out; E.gate = (const float*)(p.ws + OFF_MOD) + 5 * 6144; E.out = p.out;
                  E.lng = p.pln_g + 2048; E.lnb = p.pln_b + 2048; E.mod1 = nullptr; E.xm1 = nullptr; E.rstat = (float*)(p.ws + OFF_RSTAT); E.xb = &xbar;
                  pg8::gemm_phase(lds, g, S, E); } PH_END(12)
        if (coop) for (int es_ = 0; es_ < EXTRA_SYNCS; ++es_) GRID_SYNC();
}

#ifndef MK_SPLIT
#define MK_SPLIT 0
#endif
extern "C" void kernel_launch(void* const* d_in, const int* in_sizes, int n_in, void* d_out, int out_size, void* d_ws, size_t ws_size, hipStream_t stream) {
    constexpr int LDS_BYTES = 131072 + 256;
    static int grid = 0;
    if (grid == 0) {
        if (n_in != 22 || out_size != 8192 * 2048 || ws_size < WS_END) { fprintf(stderr, "kernel_launch: unexpected shapes (n_in %d out %d ws %zu need %zu)\n", n_in, out_size, ws_size, (size_t)WS_END); grid = -1; return; }
        int dev = 0, cus = 0, per_cu = 0;
        hipGetDevice(&dev); hipDeviceGetAttribute(&cus, hipDeviceAttributeMultiprocessorCount, dev);
        if (hipFuncSetAttribute((const void*)fwd_megakernel, hipFuncAttributeMaxDynamicSharedMemorySize, LDS_BYTES) != hipSuccess) { fprintf(stderr, "kernel_launch: hipFuncSetAttribute failed\n"); grid = -1; return; }
        hipOccupancyMaxActiveBlocksPerMultiprocessor(&per_cu, (const void*)fwd_megakernel, 512, LDS_BYTES);
        (void)hipGetLastError();
        if (per_cu < 1) per_cu = 1;
        grid = cus;
        if (grid < 256) fprintf(stderr, "kernel_launch: only %d CUs; this kernel wants 256\n", grid);
        if (grid > 256) grid = 256;
    }
    if (grid < 0) return;
    Params p{};
    const float** pp = (const float**)&p;
    for (int i = 0; i < 22; ++i) pp[i] = (const float*)d_in[i];
    p.out = (float*)d_out; p.ws = (unsigned char*)d_ws;
    if (hipMemsetAsync((char*)d_ws + OFF_BAR, 0, 16384, stream) != hipSuccess) { fprintf(stderr, "kernel_launch: memset of barrier words failed\n"); return; }
#if MK_SPLIT
    for (int ph = 0; ph < 13; ++ph) { int lo = ph, hi = ph + 1, coop = 0; hipLaunchKernelGGL(fwd_megakernel, dim3(grid), dim3(512), LDS_BYTES, stream, p, lo, hi, coop); }
#else
    int lo = 0, hi = 13, coop = 1;
    void* args[] = {&p, &lo, &hi, &coop};
    hipError_t e = hipLaunchCooperativeKernel((const void*)fwd_megakernel, dim3(grid), dim3(512), args, LDS_BYTES, stream);
    if (e != hipSuccess) fprintf(stderr, "cooperative launch failed: %s (grid %d)\n", hipGetErrorString(e), grid);
#endif
}
```
